# Optimizing an MI355X kernel written in HIP

```python
import jax, jax.numpy as jnp
from jax import lax
import numpy as np

D_MODEL = 2048
BATCH = 2
SEQ = 4096
DEPTH = 2

CHUNK = 64
QBLOCK = 128
N_META = 16
PAD = QBLOCK - N_META
N_A = DEPTH // 2
N_B = DEPTH - N_A
GLA_HEADS = 4
GLA_KD = D_MODEL // 2
GLA_VD = D_MODEL
GLA_DK = GLA_KD // GLA_HEADS
GLA_DV = GLA_VD // GLA_HEADS
GATE_RANK = 16
GATE_TAU = 16.0
SB_HEAD_DIM = 128
SB_HEADS = D_MODEL // SB_HEAD_DIM
D_FF = -(-8 * D_MODEL // (3 * 256)) * 256
EPS = 1e-6

kernel_name = 'yoco_gla_stickbreaking_encoder'


def rms_norm(x, g):
    xf = x.astype(jnp.float32)
    y = xf * lax.rsqrt(jnp.mean(xf * xf, axis=-1, keepdims=True) + EPS)
    return (y * g.astype(jnp.float32)).astype(x.dtype)


def swiglu_ffn(h, g, w_gate, w_up, w_down):
    y = rms_norm(h, g)
    return (jax.nn.silu(y @ w_gate) * (y @ w_up)) @ w_down


def gla_mixer(h, valid, g_norm, w_in, w_gate_up, b_gate, g_onorm, w_out):
    B, L, _ = h.shape
    n_c = L // CHUNK
    y = rms_norm(h, g_norm)
    proj = y @ w_in
    q, k, v, g, a = jnp.split(proj, [GLA_KD, 2 * GLA_KD, 2 * GLA_KD + GLA_VD, 2 * GLA_KD + 2 * GLA_VD], axis=-1)
    k = k * valid[None, :, None]
    la = jax.nn.log_sigmoid((a @ w_gate_up + b_gate).astype(jnp.float32)) / GATE_TAU

    def heads(t, dh):
        return t.astype(jnp.float32).reshape(B, n_c, CHUNK, GLA_HEADS, dh).transpose(0, 1, 3, 2, 4)

    q = heads(q, GLA_DK) * GLA_DK ** -0.5
    k = heads(k, GLA_DK)
    v = heads(v, GLA_DV)
    bcum = jnp.cumsum(heads(la, GLA_DK), axis=3)
    ref = bcum[:, :, :, CHUNK // 2 - 1:CHUNK // 2, :]
    s_lo = jnp.einsum('bnhtd,bnhsd->bnhts', q * jnp.exp(bcum - ref), k * jnp.exp(ref - bcum))
    s_up = jnp.einsum('bnhtd,bnhsd->bnhts', q * jnp.exp(ref - bcum), k * jnp.exp(bcum - ref))
    idx = jnp.arange(CHUNK)
    scores = jnp.where(idx[:, None] >= idx[None, :], s_lo, s_up)
    o_intra = jnp.einsum('bnhts,bnhsv->bnhtv', scores, v)
    b_last = bcum[:, :, :, -1:, :]
    k_state = k * jnp.exp(b_last - bcum)
    q_inter = q * jnp.exp(bcum)
    chunk_decay = jnp.exp(b_last[:, :, :, 0, :])

    def step(S, inp):
        qc, kc, vc, dc = inp
        o_c = jnp.einsum('bhtd,bhdv->bhtv', qc, S)
        S_new = dc[..., None] * S + jnp.einsum('bhsd,bhsv->bhdv', kc, vc)
        return S_new, o_c

    xs = (jnp.moveaxis(q_inter, 1, 0), jnp.moveaxis(k_state, 1, 0), jnp.moveaxis(v, 1, 0), jnp.moveaxis(chunk_decay, 1, 0))
    S0 = jnp.zeros((B, GLA_HEADS, GLA_DK, GLA_DV), jnp.float32)
    _, o_inter = lax.scan(step, S0, xs)
    o = o_intra + jnp.moveaxis(o_inter, 0, 1)
    o = rms_norm(o, g_onorm)
    o = o.transpose(0, 1, 3, 2, 4).reshape(B, L, GLA_VD)
    o = o * jax.nn.silu(g.astype(jnp.float32))
    return o.astype(h.dtype) @ w_out


def stick_breaking_mixer(h, k_sh, v_sh, key_valid, g_norm, w_q, g_q, w_o):
    B, L, _ = h.shape
    y = rms_norm(h, g_norm)
    q = rms_norm((y @ w_q).reshape(B, L, SB_HEADS, SB_HEAD_DIM), g_q).astype(jnp.float32) * SB_HEAD_DIM ** -0.5
    pos = jnp.arange(L)
    outs = []
    for blk in range(L // QBLOCK):
        q0 = blk * QBLOCK
        kend = q0 + QBLOCK
        z = jnp.einsum('bqhd,bkhd->bhqk', q[:, q0:kend], k_sh[:, :kend])
        valid = (pos[None, :kend] < pos[q0:kend, None]) & key_valid[None, :kend]
        l_fail = jnp.where(valid, jax.nn.log_sigmoid(-z), 0.0)
        suffix = lax.cumsum(l_fail, axis=3, reverse=True) - l_fail
        att = jnp.where(valid, jnp.exp(jax.nn.log_sigmoid(z) + suffix), 0.0)
        outs.append(jnp.einsum('bhqk,bkhd->bqhd', att, v_sh[:, :kend]))
    o = jnp.concatenate(outs, axis=1).reshape(B, L, D_MODEL)
    return o.astype(h.dtype) @ w_o


def setup_inputs(seed: int = 0) -> dict:
    key = jax.random.key(seed)
    ks = jax.random.split(key, 19)
    f32 = jnp.float32

    def dense(k, shape, fan_in):
        return jax.random.normal(k, shape, f32) * fan_in ** -0.5

    def gain(k, shape):
        return 1.0 + 0.02 * jax.random.normal(k, shape, f32)

    n_in_a = 2 * GLA_KD + 2 * GLA_VD + GATE_RANK
    return {
        'x': jax.random.normal(ks[0], (BATCH, SEQ, D_MODEL), f32),
        'meta_tokens': jax.random.normal(ks[1], (N_META, D_MODEL), f32),
        'g_norm_a': gain(ks[2], (N_A, D_MODEL)),
        'w_in_a': dense(ks[3], (N_A, D_MODEL, n_in_a), D_MODEL),
        'w_gate_up_a': dense(ks[4], (N_A, GATE_RANK, GLA_KD), GATE_RANK),
        'b_gate_a': 0.1 * jax.random.normal(ks[5], (N_A, GLA_KD), f32),
        'g_onorm_a': gain(ks[6], (N_A, GLA_DV)),
        'w_out_a': dense(ks[7], (N_A, GLA_VD, D_MODEL), GLA_VD),
        'g_kv_norm': gain(ks[8], (D_MODEL,)),
        'w_kv': dense(ks[9], (D_MODEL, 2 * D_MODEL), D_MODEL),
        'g_k': gain(ks[10], (SB_HEAD_DIM,)),
        'g_norm_b': gain(ks[11], (N_B, D_MODEL)),
        'w_q_b': dense(ks[12], (N_B, D_MODEL, D_MODEL), D_MODEL),
        'g_q_b': gain(ks[13], (N_B, SB_HEAD_DIM)),
        'w_o_b': dense(ks[14], (N_B, D_MODEL, D_MODEL), D_MODEL),
        'g_ffn_norm': gain(ks[15], (DEPTH, D_MODEL)),
        'w_ffn_gate': dense(ks[16], (DEPTH, D_MODEL, D_FF), D_MODEL),
        'w_ffn_up': dense(ks[17], (DEPTH, D_MODEL, D_FF), D_MODEL),
        'w_ffn_down': dense(ks[18], (DEPTH, D_FF, D_MODEL), D_FF),
    }


def reference(x, meta_tokens, g_norm_a, w_in_a, w_gate_up_a, b_gate_a, g_onorm_a, w_out_a,
              g_kv_norm, w_kv, g_k, g_norm_b, w_q_b, g_q_b, w_o_b,
              g_ffn_norm, w_ffn_gate, w_ffn_up, w_ffn_down):
    B = x.shape[0]
    h = jnp.concatenate([
        jnp.zeros((B, PAD, D_MODEL), x.dtype),
        jnp.broadcast_to(meta_tokens.astype(x.dtype)[None], (B, N_META, D_MODEL)),
        x,
    ], axis=1)
    L = h.shape[1]
    key_valid = jnp.arange(L) >= PAD
    valid = key_valid.astype(x.dtype)
    k_sh = v_sh = None
    for layer in range(DEPTH):
        if layer < N_A:
            h = h + gla_mixer(h, valid, g_norm_a[layer], w_in_a[layer], w_gate_up_a[layer],
                              b_gate_a[layer], g_onorm_a[layer], w_out_a[layer])
        else:
            if layer == N_A:
                kv = rms_norm(h, g_kv_norm) @ w_kv
                k_sh, v_sh = jnp.split(kv, 2, axis=-1)
                k_sh = rms_norm(k_sh.reshape(B, L, SB_HEADS, SB_HEAD_DIM), g_k).astype(jnp.float32)
                v_sh = v_sh.reshape(B, L, SB_HEADS, SB_HEAD_DIM).astype(jnp.float32)
            j = layer - N_A
            h = h + stick_breaking_mixer(h, k_sh, v_sh, key_valid, g_norm_b[j], w_q_b[j], g_q_b[j], w_o_b[j])
        h = h + swiglu_ffn(h, g_ffn_norm[layer], w_ffn_gate[layer], w_ffn_up[layer], w_ffn_down[layer])
    return h[:, PAD + N_META:]
```

```cpp
#include <hip/hip_runtime.h>
#include <hip/hip_cooperative_groups.h>
#include <cstdio>
#include <cstdint>
namespace cg = cooperative_groups;

#define LAS __attribute__((address_space(3)))
typedef unsigned short bf16_t;
typedef short bf16x8 __attribute__((ext_vector_type(8)));
typedef float f32x4 __attribute__((ext_vector_type(4)));
typedef float f32x16 __attribute__((ext_vector_type(16)));
typedef unsigned u32x4 __attribute__((ext_vector_type(4)));
typedef unsigned u32x2 __attribute__((ext_vector_type(2)));

constexpr int BATCH = 2, SEQ = 4096, LTOT = 4224, DM = 2048, MTOT = BATCH * LTOT;
constexpr int PADN = 112, OFFS = 128;
constexpr int DFF = 5632, NIN = 6160;
constexpr int GKD = 1024;
constexpr float EPS = 1e-6f;

constexpr size_t SZ_WIN = (size_t)6144 * 2048 * 2, SZ_SQ = (size_t)2048 * 2048 * 2, SZ_WF = (size_t)11264 * 2048 * 2, SZ_WD = (size_t)2048 * 5632 * 2;
constexpr size_t WS_WIN = 0, WS_WOUTA = WS_WIN + SZ_WIN, WS_WF0 = WS_WOUTA + SZ_SQ, WS_WD0 = WS_WF0 + SZ_WF;
constexpr size_t WS_WKVQ = WS_WD0 + SZ_WD, WS_WOB = WS_WKVQ + SZ_WIN, WS_WF1 = WS_WOB + SZ_SQ, WS_WD1 = WS_WF1 + SZ_WF;
constexpr size_t WS_XN = WS_WD1 + SZ_WD;
constexpr size_t SZ_ROW2K = (size_t)MTOT * 2048 * 2, SZ_ROW1K = (size_t)MTOT * 1024 * 2;
constexpr size_t WS_R = WS_XN + SZ_ROW2K;
constexpr size_t WS_QA = WS_R, WS_KA = WS_QA + SZ_ROW1K, WS_VTA = WS_KA + SZ_ROW1K, WS_GA = WS_VTA + SZ_ROW2K, WS_KST = WS_GA + SZ_ROW2K;
constexpr size_t WS_REND = WS_KST + SZ_ROW1K;
constexpr size_t WS_ACT = WS_R;
constexpr size_t WS_KR = WS_R, WS_QR = WS_KR + SZ_ROW2K, WS_VTB = WS_QR + SZ_ROW2K;
static_assert(WS_ACT + (size_t)MTOT * DFF * 2 <= WS_REND && WS_VTB + SZ_ROW2K <= WS_REND, "region");
constexpr size_t WS_HO = WS_REND;
constexpr size_t WS_AG = WS_HO + (size_t)MTOT * 2048 * 4;
constexpr size_t WS_DC = WS_AG + (size_t)MTOT * 16 * 4;
constexpr size_t WS_END = WS_DC + (size_t)528 * 256 * 4;

constexpr int LDS_BYTES = 147456;

typedef __bf16 bf16x2_t __attribute__((ext_vector_type(2)));
typedef float f32x2_t __attribute__((ext_vector_type(2)));
__device__ __forceinline__ unsigned cvt_pk_bf16_v(float lo, float hi) { const f32x2_t v = {lo, hi}; const bf16x2_t b = __builtin_convertvector(v, bf16x2_t); return __builtin_bit_cast(unsigned, b); }
__device__ __forceinline__ unsigned cvt_pk_bf16(float lo, float hi) { unsigned r; asm("v_cvt_pk_bf16_f32 %0, %1, %2" : "=v"(r) : "v"(lo), "v"(hi)); return r; }
__device__ __forceinline__ float bf_lo(unsigned u) { return __builtin_bit_cast(float, u << 16); }
__device__ __forceinline__ float bf_hi(unsigned u) { return __builtin_bit_cast(float, u & 0xffff0000u); }
__device__ __forceinline__ float wave_sum(float v) {
#pragma unroll
    for (int o = 1; o < 64; o <<= 1) v += __shfl_xor(v, o);
    return v;
}
__device__ __forceinline__ int opaque_tid() { int t = threadIdx.x; asm volatile("" : "+v"(t)); return t; }
__device__ __forceinline__ unsigned char* opaque_ptr(unsigned char* q) { asm volatile("" : "+s"(q)); return q; }
__device__ __forceinline__ float silu_f(float x) { return x / (1.f + __expf(-x)); }
__device__ __forceinline__ float log_sigmoid_f(float x) { return fminf(x, 0.f) - __logf(1.f + __expf(-fabsf(x))); }

namespace pg8 {
constexpr int BM = 256, BK = 64, HALF = 128, HTB = HALF * BK * 2, NXCD = 8, WGM = 8;
__host__ __device__ __forceinline__ int lds_byte(int r, int c) { const int st = (r >> 4) * 2 + (c >> 5), rr = r & 15, cc = c & 31, ob = rr * 64 + cc * 2; return st * 1024 + (ob ^ (((ob >> 9) & 1) << 5)); }
__host__ __device__ __forceinline__ void stage_rc(int b, int& R, int& C) { const int st = b / 1024, sb = b % 1024, swz = sb ^ (((sb >> 9) & 1) << 5); R = (st >> 1) * 16 + swz / 64; C = (st & 1) * 32 + (swz % 64) / 2; }
__host__ __device__ __forceinline__ int perm32(int rho) { const int n = rho >> 4, i = rho & 15; return 8 * (i >> 2) + 4 * n + (i & 3); }
struct Unit { int pm, pn; };
struct Gemm { const bf16_t* A; const bf16_t* Bt; int M, N, K; };
struct StaticOrder {
    int nM, nN, nwg, G, c;
    __host__ __device__ void init(int M, int N, int G_, int c_) { nM = M / BM; nN = N / BM; nwg = nM * nN; G = G_; c = c_; }
    __host__ __device__ bool next(int i, Unit& u) const {
        const long L = (long)i * G + c; if (L >= nwg) return false;
        int wgid = (int)L; { const int q = nwg / NXCD, r = nwg % NXCD, xcd = wgid % NXCD, off = wgid / NXCD; wgid = (xcd < r ? xcd * (q + 1) : r * (q + 1) + (xcd - r) * q) + off; }
        const int nig = WGM * nN, gid = wgid / nig, fm = gid * WGM, gsz = (nM - fm) < WGM ? (nM - fm) : WGM;
        u.pm = fm + ((wgid % nig) % gsz); u.pn = (wgid % nig) / gsz; return true;
    }
    __device__ __forceinline__ void a_ready(const Unit&) const {}
    __device__ __forceinline__ void done(const Unit&) const {}
};
template <class Epi, class Sched, bool ALIGN_EPI = false, bool SP2 = false>
__device__ __forceinline__ void gemm_phase(LAS unsigned char* lds, const Gemm g, const Sched& S, const Epi& E) {
    const int tid = opaque_tid(), wid = __builtin_amdgcn_readfirstlane(tid >> 6), lane = tid & 63, wr = wid >> 2, wc = wid & 3, fr = lane & 15, fq = lane >> 4;
    const int K = g.K, nt = K / BK;
    unsigned voffA[2], voffB[2];
#pragma unroll
    for (int i = 0; i < 2; ++i) { int R, C; stage_rc(tid * 16 + i * 8192, R, C); const int Rb = Epi::PERM ? ((R & ~31) + perm32(R & 31)) : R;
        voffA[i] = (unsigned)(R * K + C) * 2u; voffB[i] = (unsigned)(Rb * K + C) * 2u; }
    const size_t kstep = (size_t)(BK * 2);
    const size_t hstep = (size_t)HALF * K * 2;
    const size_t tstep = 2 * hstep;
    const unsigned ldsw = (unsigned)wid * 1024u;
    const int aoff = lds_byte(wr * 64 + fr, fq * 8), boff = lds_byte(wc * 32 + fr, fq * 8);
#define PG8_SA(b, h) (((b) * 2 + (h)) * HTB)
#define PG8_SB(b, h) ((4 + (b) * 2 + (h)) * HTB)
#define PG8_STAGE(bufoff, gbase, voff) do { _Pragma("unroll") for (int _i = 0; _i < 2; ++_i) \
        __builtin_amdgcn_global_load_lds((const unsigned*)((const char*)(gbase) + (voff)[_i]), (LAS unsigned*)(lds + (bufoff) + ldsw + _i * 8192), 16, 0, 0); } while (0)
#define PG8_LDA(dst, b, h) do { _Pragma("unroll") for (int m = 0; m < 4; ++m) _Pragma("unroll") for (int k = 0; k < 2; ++k) dst[m][k] = *(const LAS bf16x8*)(lds + PG8_SA(b, h) + aoff + m * 2048 + k * 1024); } while (0)
#define PG8_LDB(dst, b, h) do { _Pragma("unroll") for (int n = 0; n < 2; ++n) _Pragma("unroll") for (int k = 0; k < 2; ++k) dst[n][k] = *(const LAS bf16x8*)(lds + PG8_SB(b, h) + boff + n * 2048 + k * 1024); } while (0)
#define PG8_MMA(ai, bj, At, Bt) do { __builtin_amdgcn_s_setprio(1); _Pragma("unroll") for (int m = 0; m < 4; ++m) _Pragma("unroll") for (int n = 0; n < 2; ++n) _Pragma("unroll") for (int k = 0; k < 2; ++k) \
        acc[ai][bj][m][n] = __builtin_amdgcn_mfma_f32_16x16x32_bf16(Bt[n][k], At[m][k], acc[ai][bj][m][n], 0, 0, 0); __builtin_amdgcn_s_setprio(0); } while (0)
#define PG8_WAIT_V(n) asm volatile("s_waitcnt vmcnt(" #n ")" ::: "memory")
#define PG8_WAIT_L(n) asm volatile("s_waitcnt lgkmcnt(" #n ")" ::: "memory")
#define PG8_BAR __builtin_amdgcn_s_barrier()
#define PG8_SCHED __builtin_amdgcn_sched_barrier(0)
    Unit cur, nxt; int ui = 0;
    if (!S.next(0, cur)) return;
    f32x4 acc[2][2][4][2];
#pragma unroll
    for (int a = 0; a < 2; ++a)
#pragma unroll
        for (int b = 0; b < 2; ++b)
#pragma unroll
            for (int m = 0; m < 4; ++m)
#pragma unroll
                for (int n = 0; n < 2; ++n) acc[a][b][m][n] = (f32x4){0.f, 0.f, 0.f, 0.f};
    bf16x8 At[4][2], B0[2][2], B1[2][2];
    const char* cA = (const char*)g.A + (size_t)cur.pm * tstep; const char* cB = (const char*)g.Bt + (size_t)cur.pn * tstep;
    S.a_ready(cur);
    if constexpr (SP2) {
        PG8_STAGE(PG8_SB(0, 0), cB, voffB); PG8_STAGE(PG8_SB(0, 1), cB + hstep, voffB); PG8_STAGE(PG8_SA(0, 0), cA, voffA); PG8_STAGE(PG8_SA(0, 1), cA + hstep, voffA);
        if (wr == 1) PG8_BAR;
        PG8_WAIT_V(2); PG8_BAR;
        PG8_STAGE(PG8_SB(1, 0), cB + kstep, voffB); PG8_STAGE(PG8_SA(1, 0), cA + kstep, voffA); PG8_STAGE(PG8_SB(1, 1), cB + hstep + kstep, voffB);
        PG8_WAIT_V(6); PG8_BAR;
    } else {
        PG8_STAGE(PG8_SB(0, 0), cB, voffB); PG8_STAGE(PG8_SA(0, 0), cA, voffA); PG8_STAGE(PG8_SB(0, 1), cB + hstep, voffB); PG8_STAGE(PG8_SA(0, 1), cA + hstep, voffA);
        if (wr == 1) PG8_BAR;
        PG8_WAIT_V(4); PG8_BAR;
        PG8_STAGE(PG8_SB(1, 0), cB + kstep, voffB); PG8_STAGE(PG8_SA(1, 0), cA + kstep, voffA); PG8_STAGE(PG8_SB(1, 1), cB + hstep + kstep, voffB);
        PG8_WAIT_V(6); PG8_BAR;
    }
    for (;;) {
        const bool has_next = S.next(ui + 1, nxt);
        const char* nA = has_next ? (const char*)g.A + (size_t)nxt.pm * tstep : cA; const char* nB = has_next ? (const char*)g.Bt + (size_t)nxt.pn * tstep : cB;
        for (int t = 0; t < nt; t += 2) {
            const bool last = (t == nt - 2);
            const char* a1 = cA + (size_t)(t + 1) * kstep;
            const char* a2 = last ? nA : cA + (size_t)(t + 2) * kstep; const char* b2 = last ? nB : cB + (size_t)(t + 2) * kstep;
            const char* a3 = a2 + kstep; const char* b3 = b2 + kstep;
            if (last && has_next) S.a_ready(nxt);
            if constexpr (SP2) {
            PG8_LDB(B0, 0, 0); PG8_LDB(B1, 0, 1); PG8_SCHED; PG8_LDA(At, 0, 0); PG8_STAGE(PG8_SA(1, 1), a1 + hstep, voffA);
            PG8_WAIT_V(8); PG8_WAIT_L(0); PG8_BAR; PG8_MMA(0, 0, At, B0); PG8_MMA(0, 1, At, B1); PG8_BAR; PG8_SCHED;
            PG8_LDA(At, 0, 1); PG8_STAGE(PG8_SB(0, 0), b2, voffB); PG8_STAGE(PG8_SB(0, 1), b2 + hstep, voffB); PG8_STAGE(PG8_SA(0, 0), a2, voffA);
            PG8_WAIT_V(8); PG8_WAIT_L(0); PG8_BAR; PG8_MMA(1, 0, At, B0); PG8_MMA(1, 1, At, B1); PG8_BAR; PG8_SCHED;
            PG8_LDB(B0, 1, 0); PG8_LDB(B1, 1, 1); PG8_SCHED; PG8_LDA(At, 1, 0); PG8_STAGE(PG8_SA(0, 1), a2 + hstep, voffA);
            PG8_WAIT_V(8); PG8_WAIT_L(0); PG8_BAR; PG8_MMA(0, 0, At, B0); PG8_MMA(0, 1, At, B1); PG8_BAR; PG8_SCHED;
            PG8_LDA(At, 1, 1); PG8_STAGE(PG8_SB(1, 0), b3, voffB); PG8_STAGE(PG8_SB(1, 1), b3 + hstep, voffB); PG8_STAGE(PG8_SA(1, 0), a3, voffA);
            PG8_WAIT_V(8); PG8_WAIT_L(0); PG8_BAR; PG8_MMA(1, 0, At, B0); PG8_MMA(1, 1, At, B1); PG8_BAR; PG8_SCHED;
            } else {
            PG8_LDB(B0, 0, 0); PG8_SCHED; PG8_LDA(At, 0, 0); PG8_STAGE(PG8_SA(1, 1), a1 + hstep, voffA);
            PG8_WAIT_L(8); PG8_BAR; PG8_WAIT_L(0); PG8_MMA(0, 0, At, B0); PG8_BAR; PG8_SCHED;
            PG8_LDB(B1, 0, 1); PG8_STAGE(PG8_SB(0, 0), b2, voffB);
            PG8_BAR; PG8_WAIT_L(0); PG8_MMA(0, 1, At, B1); PG8_BAR;
            PG8_LDA(At, 0, 1); PG8_STAGE(PG8_SA(0, 0), a2, voffA);
            PG8_BAR; PG8_WAIT_L(0); PG8_MMA(1, 0, At, B0); PG8_BAR; PG8_SCHED;
            PG8_STAGE(PG8_SB(0, 1), b2 + hstep, voffB);
            PG8_WAIT_V(6); PG8_BAR; PG8_MMA(1, 1, At, B1); PG8_BAR;
            PG8_LDB(B0, 1, 0); PG8_SCHED; PG8_LDA(At, 1, 0); PG8_STAGE(PG8_SA(0, 1), a2 + hstep, voffA);
            PG8_WAIT_L(8); PG8_BAR; PG8_WAIT_L(0); PG8_MMA(0, 0, At, B0); PG8_BAR; PG8_SCHED;
            PG8_LDB(B1, 1, 1); PG8_STAGE(PG8_SB(1, 0), b3, voffB);
            PG8_BAR; PG8_WAIT_L(0); PG8_MMA(0, 1, At, B1); PG8_BAR;
            PG8_LDA(At, 1, 1); PG8_STAGE(PG8_SA(1, 0), a3, voffA);
            PG8_BAR; PG8_WAIT_L(0); PG8_MMA(1, 0, At, B0); PG8_BAR; PG8_SCHED;
            PG8_STAGE(PG8_SB(1, 1), b3 + hstep, voffB);
            PG8_WAIT_V(6); PG8_BAR; PG8_MMA(1, 1, At, B1); PG8_BAR;
            }
        }
        if constexpr (ALIGN_EPI) { if (wr == 0) PG8_BAR; }
        if constexpr (!Epi::AFTER_DRAIN) { E(acc, cur, wr, wc, fr, fq); S.done(cur); }
        if (!has_next) break;
#pragma unroll
        for (int a = 0; a < 2; ++a)
#pragma unroll
            for (int b = 0; b < 2; ++b)
#pragma unroll
                for (int m = 0; m < 4; ++m)
#pragma unroll
                    for (int n = 0; n < 2; ++n) acc[a][b][m][n] = (f32x4){0.f, 0.f, 0.f, 0.f};
        cur = nxt; cA = nA; cB = nB; ++ui;
        if constexpr (ALIGN_EPI) { if (wr == 1) PG8_BAR; }
    }
    PG8_WAIT_V(0);
    if constexpr (!ALIGN_EPI) { if (wr == 0) PG8_BAR; }
    PG8_BAR;
#undef PG8_SA
#undef PG8_SB
#undef PG8_STAGE
#undef PG8_LDA
#undef PG8_LDB
#undef PG8_MMA
#undef PG8_WAIT_V
#undef PG8_WAIT_L
#undef PG8_BAR
#undef PG8_SCHED
}
}

struct Params {
    const float *x, *meta, *g_norm_a, *w_in_a, *w_gate_up_a, *b_gate_a, *g_onorm_a, *w_out_a, *g_kv_norm, *w_kv, *g_k, *g_norm_b, *w_q_b, *g_q_b, *w_o_b,
        *g_ffn_norm, *w_ffn_gate, *w_ffn_up, *w_ffn_down;
    float* out;
    unsigned char* ws;
    int ph_lo, ph_hi;
};

__device__ __forceinline__ const float* h0_row(const Params& p, int r) {
    const int b = r >= LTOT ? 1 : 0, pos = r - b * LTOT;
    if (pos < PADN) return nullptr;
    if (pos < OFFS) return p.meta + (size_t)(pos - PADN) * DM;
    return p.x + ((size_t)b * SEQ + (pos - OFFS)) * DM;
}

struct EpiIn {
    static constexpr bool PERM = true, AFTER_DRAIN = false;
    bf16_t *QA, *KA, *VTA, *GA; float one;
    __device__ __forceinline__ void operator()(const f32x4 (&acc)[2][2][4][2], const pg8::Unit& u, int wr, int wc, int fr, int fq) const {
        const int pn = u.pn;
#pragma unroll
        for (int ai = 0; ai < 2; ++ai)
#pragma unroll
            for (int m = 0; m < 4; ++m) {
                const int r = u.pm * 256 + ai * 128 + wr * 64 + m * 16 + fr;
#pragma unroll
                for (int bj = 0; bj < 2; ++bj) {
                    const int c = pn * 256 + bj * 128 + wc * 32 + fq * 8;
                    const f32x4 v0 = acc[ai][bj][m][0] * one, v1 = acc[ai][bj][m][1] * one;
                    if (pn < 4) {
                        const float sc = 0.0625f;
                        u32x4 w = {cvt_pk_bf16(v0[0] * sc, v0[1] * sc), cvt_pk_bf16(v0[2] * sc, v0[3] * sc), cvt_pk_bf16(v1[0] * sc, v1[1] * sc), cvt_pk_bf16(v1[2] * sc, v1[3] * sc)};
                        *(u32x4*)(QA + (size_t)r * GKD + c) = w;
                    } else if (pn < 8) {
                        u32x4 w = {cvt_pk_bf16(v0[0], v0[1]), cvt_pk_bf16(v0[2], v0[3]), cvt_pk_bf16(v1[0], v1[1]), cvt_pk_bf16(v1[2], v1[3])};
                        *(u32x4*)(KA + (size_t)r * GKD + (c - 1024)) = w;
                    } else if (pn < 16) {
                        const int cv = c - 2048, hh = cv >> 9, dv = cv & 511;
                        const int b = r >= LTOT ? 1 : 0, pos = r - b * LTOT;
                        bf16_t* dst = VTA + ((size_t)((b * 4 + hh) * 512 + dv)) * LTOT + pos;
                        const unsigned w0 = cvt_pk_bf16(v0[0], v0[1]), w1 = cvt_pk_bf16(v0[2], v0[3]), w2 = cvt_pk_bf16(v1[0], v1[1]), w3 = cvt_pk_bf16(v1[2], v1[3]);
                        dst[0] = (bf16_t)w0; dst[(size_t)LTOT] = (bf16_t)(w0 >> 16); dst[(size_t)2 * LTOT] = (bf16_t)w1; dst[(size_t)3 * LTOT] = (bf16_t)(w1 >> 16);
                        dst[(size_t)4 * LTOT] = (bf16_t)w2; dst[(size_t)5 * LTOT] = (bf16_t)(w2 >> 16); dst[(size_t)6 * LTOT] = (bf16_t)w3; dst[(size_t)7 * LTOT] = (bf16_t)(w3 >> 16);
                    } else {
                        u32x4 w = {cvt_pk_bf16(silu_f(v0[0]), silu_f(v0[1])), cvt_pk_bf16(silu_f(v0[2]), silu_f(v0[3])), cvt_pk_bf16(silu_f(v1[0]), silu_f(v1[1])), cvt_pk_bf16(silu_f(v1[2]), silu_f(v1[3]))};
                        *(u32x4*)(GA + (size_t)r * DM + (c - 4096)) = w;
                    }
                }
            }
    }
};
struct EpiKvq {
    static constexpr bool PERM = true, AFTER_DRAIN = false;
    bf16_t *KR, *VTB, *QR; float one;
    __device__ __forceinline__ void operator()(const f32x4 (&acc)[2][2][4][2], const pg8::Unit& u, int wr, int wc, int fr, int fq) const {
        const int pn = u.pn;
#pragma unroll
        for (int ai = 0; ai < 2; ++ai)
#pragma unroll
            for (int m = 0; m < 4; ++m) {
                const int r = u.pm * 256 + ai * 128 + wr * 64 + m * 16 + fr;
#pragma unroll
                for (int bj = 0; bj < 2; ++bj) {
                    const int c = pn * 256 + bj * 128 + wc * 32 + fq * 8;
                    const f32x4 v0 = acc[ai][bj][m][0] * one, v1 = acc[ai][bj][m][1] * one;
                    const unsigned w0 = cvt_pk_bf16(v0[0], v0[1]), w1 = cvt_pk_bf16(v0[2], v0[3]), w2 = cvt_pk_bf16(v1[0], v1[1]), w3 = cvt_pk_bf16(v1[2], v1[3]);
                    if (pn < 8) {
                        u32x4 w = {w0, w1, w2, w3};
                        *(u32x4*)(KR + (size_t)r * DM + c) = w;
                    } else if (pn < 16) {
                        const int cv = c - 2048, hh = cv >> 7, dv = cv & 127;
                        const int b = r >= LTOT ? 1 : 0, pos = r - b * LTOT;
                        bf16_t* dst = VTB + ((size_t)((b * 16 + hh) * 128 + dv)) * LTOT + pos;
                        dst[0] = (bf16_t)w0; dst[(size_t)LTOT] = (bf16_t)(w0 >> 16); dst[(size_t)2 * LTOT] = (bf16_t)w1; dst[(size_t)3 * LTOT] = (bf16_t)(w1 >> 16);
                        dst[(size_t)4 * LTOT] = (bf16_t)w2; dst[(size_t)5 * LTOT] = (bf16_t)(w2 >> 16); dst[(size_t)6 * LTOT] = (bf16_t)w3; dst[(size_t)7 * LTOT] = (bf16_t)(w3 >> 16);
                    } else {
                        u32x4 w = {w0, w1, w2, w3};
                        *(u32x4*)(QR + (size_t)r * DM + (c - 4096)) = w;
                    }
                }
            }
    }
};
struct EpiSwiglu {
    static constexpr bool PERM = true, AFTER_DRAIN = false;
    bf16_t* ACT;
    __device__ __forceinline__ void operator()(const f32x4 (&acc)[2][2][4][2], const pg8::Unit& u, int wr, int wc, int fr, int fq) const {
#pragma unroll
        for (int ai = 0; ai < 2; ++ai)
#pragma unroll
            for (int m = 0; m < 4; ++m) {
                const int r = u.pm * 256 + ai * 128 + wr * 64 + m * 16 + fr;
                const int c = u.pn * 128 + wc * 32 + fq * 8;
                const f32x4 g0 = acc[ai][0][m][0], g1 = acc[ai][0][m][1], u0 = acc[ai][1][m][0], u1 = acc[ai][1][m][1];
                u32x4 w = {cvt_pk_bf16(silu_f(g0[0]) * u0[0], silu_f(g0[1]) * u0[1]), cvt_pk_bf16(silu_f(g0[2]) * u0[2], silu_f(g0[3]) * u0[3]),
                           cvt_pk_bf16(silu_f(g1[0]) * u1[0], silu_f(g1[1]) * u1[1]), cvt_pk_bf16(silu_f(g1[2]) * u1[2], silu_f(g1[3]) * u1[3])};
                *(u32x4*)(ACT + (size_t)r * DFF + c) = w;
            }
    }
};
template <bool SRC0, bool FINAL>
struct EpiRes {
    static constexpr bool PERM = true, AFTER_DRAIN = false;
    Params p; float* HO;
    __device__ __forceinline__ void operator()(const f32x4 (&acc)[2][2][4][2], const pg8::Unit& u, int wr, int wc, int fr, int fq) const {
#pragma unroll
        for (int ai = 0; ai < 2; ++ai)
#pragma unroll
            for (int m = 0; m < 4; ++m) {
                const int r = u.pm * 256 + ai * 128 + wr * 64 + m * 16 + fr;
                const float* src = SRC0 ? h0_row(p, r) : HO + (size_t)r * DM;
                float* dst;
                if (FINAL) { const int b = r >= LTOT ? 1 : 0, pos = r - b * LTOT; dst = pos >= OFFS ? p.out + ((size_t)b * SEQ + (pos - OFFS)) * DM : nullptr; }
                else dst = HO + (size_t)r * DM;
#pragma unroll
                for (int bj = 0; bj < 2; ++bj) {
                    const int c = u.pn * 256 + bj * 128 + wc * 32 + fq * 8;
                    f32x4 r0 = {0.f, 0.f, 0.f, 0.f}, r1 = {0.f, 0.f, 0.f, 0.f};
                    if (src) { r0 = *(const f32x4*)(src + c); r1 = *(const f32x4*)(src + c + 4); }
                    r0 += acc[ai][bj][m][0]; r1 += acc[ai][bj][m][1];
                    if (dst) { *(f32x4*)(dst + c) = r0; *(f32x4*)(dst + c + 4) = r1; }
                }
            }
    }
};

__device__ __forceinline__ void tr_region(LAS unsigned char* lds, const float* __restrict__ W, int pitch, int K, int ncols, const float* __restrict__ gain, bf16_t* dst, int mode, int row_off) {
    const int tid = opaque_tid();
    const int nN = ncols >> 6, nK = K >> 6, ntl = nN * nK;
    LAS bf16_t* tile = (LAS bf16_t*)lds;
    for (int t = blockIdx.x; t < ntl; t += gridDim.x) {
        const int kt = t / nN, ntile = t - kt * nN, k0 = kt << 6, n0 = ntile << 6;
        {
            const int n = tid & 63, kq = tid >> 6;
            float v[8];
#pragma unroll
            for (int i = 0; i < 8; ++i) v[i] = W[(size_t)(k0 + kq * 8 + i) * pitch + n0 + n];
            if (gain) {
#pragma unroll
                for (int i = 0; i < 8; ++i) v[i] *= gain[k0 + kq * 8 + i];
            }
            u32x4 o = {cvt_pk_bf16(v[0], v[1]), cvt_pk_bf16(v[2], v[3]), cvt_pk_bf16(v[4], v[5]), cvt_pk_bf16(v[6], v[7])};
            *(LAS u32x4*)(tile + n * 72 + kq * 8) = o;
        }
        __syncthreads();
        {
            const int n = tid >> 3, ch = tid & 7;
            const u32x4 o = *(LAS u32x4*)(tile + n * 72 + ch * 8);
            const int nn = n0 + n;
            const int row = mode == 0 ? row_off + nn : ((nn >> 7) * 256 + (mode == 2 ? 128 : 0) + (nn & 127));
            *(u32x4*)(dst + (size_t)row * K + k0 + ch * 8) = o;
        }
        __syncthreads();
    }
}

template <bool FIRST>
__device__ __forceinline__ void norm_phase(const Params& p, LAS unsigned char* lds) {
    const int tid = opaque_tid(), lane = tid & 63, wave = tid >> 6;
    bf16_t* XN = (bf16_t*)(p.ws + WS_XN);
    const float* HO = (const float*)(p.ws + WS_HO);
    float* AG = (float*)(p.ws + WS_AG);
    LAS float* wl = (LAS float*)lds;
    if (FIRST) {
        for (int e = tid; e < 2048 * 16; e += 512) { const int k = e >> 4, j = e & 15; wl[j * 2048 + k] = p.g_norm_a[k] * p.w_in_a[(size_t)k * NIN + 6144 + j]; }
        __syncthreads();
    }
    const int gw = blockIdx.x * 8 + wave, ngw = gridDim.x * 8;
    for (int r = gw; r < MTOT; r += ngw) {
        const float* src = FIRST ? h0_row(p, r) : HO + (size_t)r * DM;
        f32x4 v[8];
        float ss = 0.f;
#pragma unroll
        for (int j = 0; j < 8; ++j) {
            v[j] = src ? ((const f32x4*)src)[lane + 64 * j] : (f32x4){0.f, 0.f, 0.f, 0.f};
            ss += (v[j][0] * v[j][0] + v[j][1] * v[j][1]) + (v[j][2] * v[j][2] + v[j][3] * v[j][3]);
        }
        const float rstd = rsqrtf(wave_sum(ss) * (1.f / DM) + EPS);
#pragma unroll
        for (int j = 0; j < 8; ++j) {
            v[j] = v[j] * rstd;
            u32x2 o = {cvt_pk_bf16(v[j][0], v[j][1]), cvt_pk_bf16(v[j][2], v[j][3])};
            ((u32x2*)(XN + (size_t)r * DM))[lane + 64 * j] = o;
        }
        if (FIRST) {
            float outv = 0.f;
#pragma unroll
            for (int jj = 0; jj < 16; ++jj) {
                float a = 0.f;
#pragma unroll
                for (int j = 0; j < 8; ++j) { const f32x4 w4 = *(const LAS f32x4*)(wl + jj * 2048 + 4 * (lane + 64 * j)); a += (v[j][0] * w4[0] + v[j][1] * w4[1]) + (v[j][2] * w4[2] + v[j][3] * w4[3]); }
                a = wave_sum(a);
                outv = (lane == jj) ? a : outv;
            }
            if (lane < 16) AG[(size_t)r * 16 + lane] = outv;
        }
    }
}

__device__ __forceinline__ void knorm_phase(const Params& p) {
    const int tid = opaque_tid(), lane = tid & 63, wave = tid >> 6;
    bf16_t* KR = (bf16_t*)(p.ws + WS_KR);
    const int gw = blockIdx.x * 8 + wave, ngw = gridDim.x * 8;
    for (int r = gw; r < MTOT; r += ngw) {
#pragma unroll
        for (int i = 0; i < 4; ++i) {
            const int ch = lane + 64 * i;
            u32x4 w = ((const u32x4*)(KR + (size_t)r * DM))[ch];
            float f[8] = {bf_lo(w[0]), bf_hi(w[0]), bf_lo(w[1]), bf_hi(w[1]), bf_lo(w[2]), bf_hi(w[2]), bf_lo(w[3]), bf_hi(w[3])};
            float ss = 0.f;
#pragma unroll
            for (int e = 0; e < 8; ++e) ss += f[e] * f[e];
            ss += __shfl_xor(ss, 1); ss += __shfl_xor(ss, 2); ss += __shfl_xor(ss, 4); ss += __shfl_xor(ss, 8);
            const float rstd = rsqrtf(ss * (1.f / 128.f) + EPS);
            const int d0 = (ch & 15) * 8;
            const f32x4 ga = *(const f32x4*)(p.g_k + d0), gb = *(const f32x4*)(p.g_k + d0 + 4);
            u32x4 o = {cvt_pk_bf16(f[0] * rstd * ga[0], f[1] * rstd * ga[1]), cvt_pk_bf16(f[2] * rstd * ga[2], f[3] * rstd * ga[3]),
                       cvt_pk_bf16(f[4] * rstd * gb[0], f[5] * rstd * gb[1]), cvt_pk_bf16(f[6] * rstd * gb[2], f[7] * rstd * gb[3])};
            ((u32x4*)(KR + (size_t)r * DM))[ch] = o;
        }
    }
}

__device__ __forceinline__ void gla_intra_phase(const Params& p, LAS unsigned char* lds) {
    const int tid = opaque_tid(), lane = tid & 63, wave = __builtin_amdgcn_readfirstlane(tid >> 6), fr = lane & 15, fq = lane >> 4;
    bf16_t* QA = (bf16_t*)(p.ws + WS_QA); const bf16_t* KA = (const bf16_t*)(p.ws + WS_KA); const bf16_t* VTA = (const bf16_t*)(p.ws + WS_VTA);
    bf16_t* KST = (bf16_t*)(p.ws + WS_KST); float* HO = (float*)(p.ws + WS_HO); float* DCB = (float*)(p.ws + WS_DC); const float* AG = (const float*)(p.ws + WS_AG);
    constexpr int OPS = 264;
    LAS bf16_t* QLO = (LAS bf16_t*)lds; LAS bf16_t* KLO = QLO + 64 * OPS; LAS bf16_t* QUP = KLO + 64 * OPS; LAS bf16_t* KUP = QUP + 64 * OPS;
    LAS bf16_t* PS = KUP + 64 * OPS;
    LAS bf16_t* VT = (LAS bf16_t*)lds;
    for (int u = blockIdx.x; u < 528; u += gridDim.x) {
        const int b = u / 264, rem = u - b * 264, c = rem >> 2, h = rem & 3;
        const int r0 = b * LTOT + c * 64;
        const size_t row = (size_t)(r0 + lane);
        float a[16];
#pragma unroll
        for (int i = 0; i < 4; ++i) { const f32x4 t = ((const f32x4*)(AG + row * 16))[i]; a[4 * i] = t[0]; a[4 * i + 1] = t[1]; a[4 * i + 2] = t[2]; a[4 * i + 3] = t[3]; }
        for (int cc = 0; cc < 4; ++cc) {
            const int d0 = wave * 32 + cc * 8;
            const u32x4 qraw = *(const u32x4*)(QA + row * GKD + h * 256 + d0), kraw = *(const u32x4*)(KA + row * GKD + h * 256 + d0);
            const float qv[8] = {bf_lo(qraw[0]), bf_hi(qraw[0]), bf_lo(qraw[1]), bf_hi(qraw[1]), bf_lo(qraw[2]), bf_hi(qraw[2]), bf_lo(qraw[3]), bf_hi(qraw[3])};
            const float kv[8] = {bf_lo(kraw[0]), bf_hi(kraw[0]), bf_lo(kraw[1]), bf_hi(kraw[1]), bf_lo(kraw[2]), bf_hi(kraw[2]), bf_lo(kraw[3]), bf_hi(kraw[3])};
            float qlo[8], klo[8], qup[8], kup[8], qi[8];
#pragma unroll
            for (int i = 0; i < 8; ++i) {
                const int d = h * 256 + d0 + i;
                float xg = p.b_gate_a[d];
#pragma unroll
                for (int rr = 0; rr < 16; ++rr) xg += a[rr] * p.w_gate_up_a[rr * GKD + d];
                float v = log_sigmoid_f(xg) * 0.0625f;
#pragma unroll
                for (int off = 1; off < 64; off <<= 1) { const float t = __shfl_up(v, off); if (lane >= off) v += t; }
                const float ref = __shfl(v, 31), bl = __shfl(v, 63);
                const float e1 = __expf(v - ref), e2 = __expf(ref - v), ei = __expf(v), ek = __expf(bl - v);
                qlo[i] = qv[i] * e1; kup[i] = kv[i] * e1; qup[i] = qv[i] * e2; klo[i] = kv[i] * e2; qi[i] = qv[i] * ei;
                KST[(size_t)u * 16384 + (size_t)(d0 + i) * 64 + lane] = (bf16_t)(cvt_pk_bf16_v(kv[i] * ek, 0.f) & 0xffffu);
                if (lane == 0) DCB[u * 256 + d0 + i] = __expf(bl);
            }
#define PK8(x) (u32x4){cvt_pk_bf16_v(x[0], x[1]), cvt_pk_bf16_v(x[2], x[3]), cvt_pk_bf16_v(x[4], x[5]), cvt_pk_bf16_v(x[6], x[7])}
            *(LAS u32x4*)(QLO + lane * OPS + d0) = PK8(qlo);
            *(LAS u32x4*)(KLO + lane * OPS + d0) = PK8(klo);
            *(LAS u32x4*)(QUP + lane * OPS + d0) = PK8(qup);
            *(LAS u32x4*)(KUP + lane * OPS + d0) = PK8(kup);
            *(u32x4*)(QA + row * GKD + h * 256 + d0) = PK8(qi);
#undef PK8
        }
        __syncthreads();
        u32x4 vreg[8];
#pragma unroll
        for (int i = 0; i < 8; ++i) { const int ch = tid + 512 * i, dv = ch >> 3, part = ch & 7; vreg[i] = *(const u32x4*)(VTA + ((size_t)((b * 4 + h) * 512 + dv)) * LTOT + c * 64 + part * 8); }
#pragma unroll
        for (int bi = 0; bi < 2; ++bi) {
            const int blk = wave * 2 + bi, tb = blk >> 2, sb = blk & 3;
            f32x4 lo = {0.f, 0.f, 0.f, 0.f}, up = {0.f, 0.f, 0.f, 0.f};
            if (tb >= sb) {
#pragma unroll
                for (int ks = 0; ks < 8; ++ks) {
                    const bf16x8 af = *(const LAS bf16x8*)(QLO + (tb * 16 + fr) * OPS + ks * 32 + fq * 8), bf = *(const LAS bf16x8*)(KLO + (sb * 16 + fr) * OPS + ks * 32 + fq * 8);
                    lo = __builtin_amdgcn_mfma_f32_16x16x32_bf16(af, bf, lo, 0, 0, 0);
                }
            }
            if (tb <= sb) {
#pragma unroll
                for (int ks = 0; ks < 8; ++ks) {
                    const bf16x8 af = *(const LAS bf16x8*)(QUP + (tb * 16 + fr) * OPS + ks * 32 + fq * 8), bf = *(const LAS bf16x8*)(KUP + (sb * 16 + fr) * OPS + ks * 32 + fq * 8);
                    up = __builtin_amdgcn_mfma_f32_16x16x32_bf16(af, bf, up, 0, 0, 0);
                }
            }
#pragma unroll
            for (int i = 0; i < 4; ++i) {
                const int t = tb * 16 + fq * 4 + i, s = sb * 16 + fr;
                const float val = (t >= s) ? lo[i] : up[i];
                PS[t * 72 + s] = (bf16_t)(cvt_pk_bf16_v(val, 0.f) & 0xffffu);
            }
        }
        __syncthreads();
#pragma unroll
        for (int i = 0; i < 8; ++i) { const int ch = tid + 512 * i, dv = ch >> 3, part = ch & 7; *(LAS u32x4*)(VT + dv * 72 + part * 8) = vreg[i]; }
        __syncthreads();
#pragma unroll
        for (int tb = 0; tb < 4; ++tb) {
            const bf16x8 a0 = *(const LAS bf16x8*)(PS + (tb * 16 + fr) * 72 + fq * 8), a1 = *(const LAS bf16x8*)(PS + (tb * 16 + fr) * 72 + 32 + fq * 8);
#pragma unroll
            for (int j = 0; j < 4; ++j) {
                const int dvb = wave * 4 + j;
                const bf16x8 b0 = *(const LAS bf16x8*)(VT + (dvb * 16 + fr) * 72 + fq * 8), b1 = *(const LAS bf16x8*)(VT + (dvb * 16 + fr) * 72 + 32 + fq * 8);
                f32x4 o = {0.f, 0.f, 0.f, 0.f};
                o = __builtin_amdgcn_mfma_f32_16x16x32_bf16(a0, b0, o, 0, 0, 0);
                o = __builtin_amdgcn_mfma_f32_16x16x32_bf16(a1, b1, o, 0, 0, 0);
#pragma unroll
                for (int i = 0; i < 4; ++i) HO[(size_t)(r0 + tb * 16 + fq * 4 + i) * DM + h * 512 + dvb * 16 + fr] = o[i];
            }
        }
        __syncthreads();
    }
}

__device__ __forceinline__ void gla_scan_phase(const Params& p, LAS unsigned char* lds) {
    if (blockIdx.x >= 128) return;
    const int tid = opaque_tid(), lane = tid & 63, wave = __builtin_amdgcn_readfirstlane(tid >> 6), fr = lane & 15, fq = lane >> 4;
    const int id = blockIdx.x, bh = id & 7, sl = id >> 3, b = bh >> 2, h = bh & 3, dv0 = sl * 32;
    const bf16_t* QA = (const bf16_t*)(p.ws + WS_QA); const bf16_t* VTA = (const bf16_t*)(p.ws + WS_VTA); const bf16_t* KST = (const bf16_t*)(p.ws + WS_KST);
    float* HO = (float*)(p.ws + WS_HO); const float* DCB = (const float*)(p.ws + WS_DC);
    LAS bf16_t* QI_s = (LAS bf16_t*)lds;
    LAS bf16_t* KS_s = (LAS bf16_t*)(lds + 33792);
    LAS bf16_t* VT_s = (LAS bf16_t*)(lds + 70656);
    LAS float* DC_s = (LAS float*)(lds + 75264);
    LAS bf16_t* ST_s = (LAS bf16_t*)(lds + 76288);
    for (int e = tid; e < 32 * 264 / 2; e += 512) ((LAS unsigned*)ST_s)[e] = 0u;
    f32x4 S[2][2];
#pragma unroll
    for (int i = 0; i < 2; ++i)
#pragma unroll
        for (int j = 0; j < 2; ++j) S[i][j] = (f32x4){0.f, 0.f, 0.f, 0.f};
    const int tb = wave & 3, vb = wave >> 2;
    u32x4 rq[4], rk[4], rv = {0u, 0u, 0u, 0u}; f32x4 rdc = {0.f, 0.f, 0.f, 0.f}; float ho[4];
#define GLA_ISSUE(cstep) do { const int _c = (cstep); const int _r0 = b * LTOT + _c * 64; const int _u = b * 264 + _c * 4 + h; \
        _Pragma("unroll") for (int i = 0; i < 4; ++i) { const int ch = tid + 512 * i; rq[i] = *(const u32x4*)(QA + (size_t)(_r0 + (ch >> 5)) * GKD + h * 256 + (ch & 31) * 8); \
            rk[i] = *(const u32x4*)(KST + (size_t)_u * 16384 + (size_t)ch * 8); } \
        if (tid < 256) rv = *(const u32x4*)(VTA + ((size_t)((b * 4 + h) * 512 + dv0 + (tid >> 3))) * LTOT + _c * 64 + (tid & 7) * 8); \
        if (tid < 64) rdc = ((const f32x4*)(DCB + _u * 256))[tid]; \
        _Pragma("unroll") for (int i = 0; i < 4; ++i) ho[i] = HO[(size_t)(_r0 + tb * 16 + fq * 4 + i) * DM + h * 512 + dv0 + vb * 16 + fr]; } while (0)
    GLA_ISSUE(0);
    for (int c = 0; c < 66; ++c) {
        const int cur = c & 1;
#pragma unroll
        for (int i = 0; i < 4; ++i) { const int ch = tid + 512 * i; *(LAS u32x4*)(QI_s + (ch >> 5) * 264 + (ch & 31) * 8) = rq[i]; *(LAS u32x4*)(KS_s + (ch >> 3) * 72 + (ch & 7) * 8) = rk[i]; }
        if (tid < 256) *(LAS u32x4*)(VT_s + (tid >> 3) * 72 + (tid & 7) * 8) = rv;
        if (tid < 64) *(LAS f32x4*)(DC_s + tid * 4) = rdc;
        float hoc[4] = {ho[0], ho[1], ho[2], ho[3]};
        const int r0 = b * LTOT + c * 64;
        if (c + 1 < 66) GLA_ISSUE(c + 1);
        __syncthreads();
        {
            f32x4 o = {0.f, 0.f, 0.f, 0.f};
            LAS const bf16_t* st = ST_s + cur * (32 * 264);
#pragma unroll
            for (int ks = 0; ks < 8; ++ks) {
                const bf16x8 af = *(const LAS bf16x8*)(QI_s + (tb * 16 + fr) * 264 + ks * 32 + fq * 8), bf = *(const LAS bf16x8*)(st + (vb * 16 + fr) * 264 + ks * 32 + fq * 8);
                o = __builtin_amdgcn_mfma_f32_16x16x32_bf16(af, bf, o, 0, 0, 0);
            }
#pragma unroll
            for (int i = 0; i < 4; ++i) HO[(size_t)(r0 + tb * 16 + fq * 4 + i) * DM + h * 512 + dv0 + vb * 16 + fr] = hoc[i] + o[i];
        }
        {
            LAS bf16_t* stn = ST_s + (cur ^ 1) * (32 * 264);
#pragma unroll
            for (int di = 0; di < 2; ++di) {
                const int db = wave * 2 + di;
                const f32x4 dc = *(const LAS f32x4*)(DC_s + db * 16 + fq * 4);
                const bf16x8 a0 = *(const LAS bf16x8*)(KS_s + (db * 16 + fr) * 72 + fq * 8), a1 = *(const LAS bf16x8*)(KS_s + (db * 16 + fr) * 72 + 32 + fq * 8);
#pragma unroll
                for (int vj = 0; vj < 2; ++vj) {
                    const bf16x8 b0 = *(const LAS bf16x8*)(VT_s + (vj * 16 + fr) * 72 + fq * 8), b1 = *(const LAS bf16x8*)(VT_s + (vj * 16 + fr) * 72 + 32 + fq * 8);
                    f32x4 s = S[di][vj] * dc;
                    s = __builtin_amdgcn_mfma_f32_16x16x32_bf16(a0, b0, s, 0, 0, 0);
                    s = __builtin_amdgcn_mfma_f32_16x16x32_bf16(a1, b1, s, 0, 0, 0);
                    S[di][vj] = s;
                    u32x2 w = {cvt_pk_bf16_v(s[0], s[1]), cvt_pk_bf16_v(s[2], s[3])};
                    *(LAS u32x2*)(stn + (vj * 16 + fr) * 264 + db * 16 + fq * 4) = w;
                }
            }
        }
        __syncthreads();
    }
#undef GLA_ISSUE
}

__device__ __forceinline__ void gla_out_phase(const Params& p) {
    const int tid = opaque_tid(), lane = tid & 63, wave = tid >> 6;
    const float* HO = (const float*)(p.ws + WS_HO); const bf16_t* GA = (const bf16_t*)(p.ws + WS_GA); bf16_t* OG = (bf16_t*)(p.ws + WS_XN);
    const int gw = blockIdx.x * 8 + wave, ngw = gridDim.x * 8;
    for (int it = gw; it < MTOT * 4; it += ngw) {
        const int r = it >> 2, h = it & 3;
        const size_t base = (size_t)r * DM + h * 512 + lane * 8;
        const f32x4 o0 = *(const f32x4*)(HO + base), o1 = *(const f32x4*)(HO + base + 4);
        float ss = (o0[0] * o0[0] + o0[1] * o0[1]) + (o0[2] * o0[2] + o0[3] * o0[3]) + (o1[0] * o1[0] + o1[1] * o1[1]) + (o1[2] * o1[2] + o1[3] * o1[3]);
        const float rstd = rsqrtf(wave_sum(ss) * (1.f / 512.f) + EPS);
        const f32x4 g0 = *(const f32x4*)(p.g_onorm_a + lane * 8), g1 = *(const f32x4*)(p.g_onorm_a + lane * 8 + 4);
        const u32x4 gw4 = *(const u32x4*)(GA + base);
        u32x4 w = {cvt_pk_bf16_v(o0[0] * rstd * g0[0] * bf_lo(gw4[0]), o0[1] * rstd * g0[1] * bf_hi(gw4[0])), cvt_pk_bf16_v(o0[2] * rstd * g0[2] * bf_lo(gw4[1]), o0[3] * rstd * g0[3] * bf_hi(gw4[1])),
                   cvt_pk_bf16_v(o1[0] * rstd * g1[0] * bf_lo(gw4[2]), o1[1] * rstd * g1[1] * bf_hi(gw4[2])), cvt_pk_bf16_v(o1[2] * rstd * g1[2] * bf_lo(gw4[3]), o1[3] * rstd * g1[3] * bf_hi(gw4[3]))};
        *(u32x4*)(OG + base) = w;
    }
}

__device__ __forceinline__ void attn_phase(const Params& p, LAS unsigned char* lds) {
    const int tid = opaque_tid(), lane = tid & 63, wave = __builtin_amdgcn_readfirstlane(tid >> 6), r = lane & 31, hh = lane >> 5;
    const bf16_t* QR = (const bf16_t*)(p.ws + WS_QR); const bf16_t* KN = (const bf16_t*)(p.ws + WS_KR); const bf16_t* VTB = (const bf16_t*)(p.ws + WS_VTB);
    bf16_t* OB = (bf16_t*)(p.ws + WS_XN);
    LAS bf16_t* K_s = (LAS bf16_t*)lds;
    LAS bf16_t* V_s = (LAS bf16_t*)(lds + 17408);
    bf16x8 Tf[2];
#pragma unroll
    for (int s = 0; s < 2; ++s)
#pragma unroll
        for (int j = 0; j < 8; ++j) { const int key = 16 * s + 8 * (j >> 2) + 4 * hh + (j & 3); Tf[s][j] = (key >= r) ? (short)0x3F80 : (short)0; }
    for (int it = blockIdx.x; it < 544; it += gridDim.x) {
        int qb; if (it < 256) qb = 16 - (it >> 5); else if (it < 512) qb = 1 + ((it - 256) >> 5); else qb = 0;
        const int bhh = it & 31, b = bhh >> 4, h = bhh & 15;
        const int q0 = -128 + 256 * qb;
        const int qpos = q0 + 32 * wave + r;
        const int qmax_w = q0 + 32 * wave + 31;
        const bool wact = qmax_w >= PADN;
        bf16x8 qf[8];
        if (wact) {
            u32x4 raw[8]; float ss = 0.f;
#pragma unroll
            for (int ks = 0; ks < 8; ++ks) {
                raw[ks] = *(const u32x4*)(QR + (size_t)(b * LTOT + qpos) * DM + h * 128 + 16 * ks + 8 * hh);
#pragma unroll
                for (int e = 0; e < 4; ++e) { const float lo = bf_lo(raw[ks][e]), hi = bf_hi(raw[ks][e]); ss += lo * lo + hi * hi; }
            }
            ss += __shfl_xor(ss, 32);
            const float sc = rsqrtf(ss * (1.f / 128.f) + EPS) * 0.08838834764831845f;
#pragma unroll
            for (int ks = 0; ks < 8; ++ks) {
                const f32x4 ga = *(const f32x4*)(p.g_q_b + 16 * ks + 8 * hh), gb = *(const f32x4*)(p.g_q_b + 16 * ks + 8 * hh + 4);
                u32x4 w = {cvt_pk_bf16_v(bf_lo(raw[ks][0]) * sc * ga[0], bf_hi(raw[ks][0]) * sc * ga[1]), cvt_pk_bf16_v(bf_lo(raw[ks][1]) * sc * ga[2], bf_hi(raw[ks][1]) * sc * ga[3]),
                           cvt_pk_bf16_v(bf_lo(raw[ks][2]) * sc * gb[0], bf_hi(raw[ks][2]) * sc * gb[1]), cvt_pk_bf16_v(bf_lo(raw[ks][3]) * sc * gb[2], bf_hi(raw[ks][3]) * sc * gb[3])};
                qf[ks] = __builtin_bit_cast(bf16x8, w);
            }
        } else {
#pragma unroll
            for (int ks = 0; ks < 8; ++ks) qf[ks] = (bf16x8){0, 0, 0, 0, 0, 0, 0, 0};
        }
        f32x16 O[4];
#pragma unroll
        for (int d = 0; d < 4; ++d)
#pragma unroll
            for (int i = 0; i < 16; ++i) O[d][i] = 0.f;
        float carry = 0.f;
        const int kt_hi = (q0 + 254) >> 6;
        u32x4 rkk[2], rvv[2];
#define ATT_ISSUE(ktile) do { const int _k0 = (ktile) * 64; \
        _Pragma("unroll") for (int i = 0; i < 2; ++i) { const int ch = tid + 512 * i; \
            rkk[i] = *(const u32x4*)(KN + (size_t)(b * LTOT + _k0 + (ch >> 4)) * DM + h * 128 + (ch & 15) * 8); \
            rvv[i] = *(const u32x4*)(VTB + ((size_t)((b * 16 + h) * 128 + (ch >> 3))) * LTOT + _k0 + (ch & 7) * 8); } } while (0)
        ATT_ISSUE(kt_hi);
        for (int kt = kt_hi; kt >= 1; --kt) {
#pragma unroll
            for (int i = 0; i < 2; ++i) { const int ch = tid + 512 * i; *(LAS u32x4*)(K_s + (ch >> 4) * 136 + (ch & 15) * 8) = rkk[i]; *(LAS u32x4*)(V_s + (ch >> 3) * 72 + (ch & 7) * 8) = rvv[i]; }
            if (kt > 1) ATT_ISSUE(kt - 1);
            __syncthreads();
            if (wact) {
#pragma unroll
                for (int sub = 1; sub >= 0; --sub) {
                    const int kb0 = kt * 64 + sub * 32;
                    if (kb0 <= qmax_w - 1 && kb0 + 31 >= PADN) {
                        f32x16 Z;
#pragma unroll
                        for (int i = 0; i < 16; ++i) Z[i] = 0.f;
#pragma unroll
                        for (int ks = 0; ks < 8; ++ks) {
                            const bf16x8 kf = *(const LAS bf16x8*)(K_s + (sub * 32 + r) * 136 + 16 * ks + 8 * hh);
                            Z = __builtin_amdgcn_mfma_f32_32x32x16_bf16(kf, qf[ks], Z, 0, 0, 0);
                        }
                        float lf[16]; float tot = 0.f; unsigned vmask = 0u;
#pragma unroll
                        for (int i = 0; i < 16; ++i) {
                            const int key = kb0 + (i & 3) + 8 * (i >> 2) + 4 * hh;
                            const bool valid = (key < qpos) && (key >= PADN);
                            vmask |= valid ? (1u << i) : 0u;
                            lf[i] = valid ? log_sigmoid_f(-Z[i]) : 0.f;
                            tot += lf[i];
                        }
                        tot += __shfl_xor(tot, 32);
                        f32x16 Y;
#pragma unroll
                        for (int i = 0; i < 16; ++i) Y[i] = 0.f;
#pragma unroll
                        for (int s = 0; s < 2; ++s) {
                            unsigned hi4[4], lo4[4];
#pragma unroll
                            for (int e = 0; e < 4; ++e) {
                                const float x0 = lf[8 * s + 2 * e], x1 = lf[8 * s + 2 * e + 1];
                                const unsigned hw = cvt_pk_bf16_v(x0, x1);
                                hi4[e] = hw; lo4[e] = cvt_pk_bf16_v(x0 - bf_lo(hw), x1 - bf_hi(hw));
                            }
                            const u32x4 hv = {hi4[0], hi4[1], hi4[2], hi4[3]}, lv = {lo4[0], lo4[1], lo4[2], lo4[3]};
                            Y = __builtin_amdgcn_mfma_f32_32x32x16_bf16(Tf[s], __builtin_bit_cast(bf16x8, hv), Y, 0, 0, 0);
                            Y = __builtin_amdgcn_mfma_f32_32x32x16_bf16(Tf[s], __builtin_bit_cast(bf16x8, lv), Y, 0, 0, 0);
                        }
                        float att[16];
#pragma unroll
                        for (int i = 0; i < 16; ++i) att[i] = ((vmask >> i) & 1u) ? __expf(Z[i] + Y[i] + carry) : 0.f;
                        carry += tot;
                        bf16x8 pa[2];
#pragma unroll
                        for (int s = 0; s < 2; ++s) {
                            const u32x4 w = {cvt_pk_bf16_v(att[8 * s], att[8 * s + 1]), cvt_pk_bf16_v(att[8 * s + 2], att[8 * s + 3]), cvt_pk_bf16_v(att[8 * s + 4], att[8 * s + 5]), cvt_pk_bf16_v(att[8 * s + 6], att[8 * s + 7])};
                            pa[s] = __builtin_bit_cast(bf16x8, w);
                        }
#pragma unroll
                        for (int dvb = 0; dvb < 4; ++dvb)
#pragma unroll
                            for (int s = 0; s < 2; ++s) {
                                const u32x2 v0 = *(const LAS u32x2*)(V_s + (dvb * 32 + r) * 72 + sub * 32 + 16 * s + 4 * hh);
                                const u32x2 v1 = *(const LAS u32x2*)(V_s + (dvb * 32 + r) * 72 + sub * 32 + 16 * s + 8 + 4 * hh);
                                const u32x4 vv = {v0[0], v0[1], v1[0], v1[1]};
                                O[dvb] = __builtin_amdgcn_mfma_f32_32x32x16_bf16(__builtin_bit_cast(bf16x8, vv), pa[s], O[dvb], 0, 0, 0);
                            }
                    }
                }
            }
            __syncthreads();
        }
#undef ATT_ISSUE
        if (wact && qpos >= PADN) {
            bf16_t* orow = OB + (size_t)(b * LTOT + qpos) * DM + h * 128;
#pragma unroll
            for (int dvb = 0; dvb < 4; ++dvb)
#pragma unroll
                for (int g = 0; g < 4; ++g) {
                    const u32x2 w = {cvt_pk_bf16_v(O[dvb][4 * g], O[dvb][4 * g + 1]), cvt_pk_bf16_v(O[dvb][4 * g + 2], O[dvb][4 * g + 3])};
                    *(u32x2*)(orow + dvb * 32 + 8 * g + 4 * hh) = w;
                }
        }
    }
}

#define GRID_SYNC() do { asm volatile("s_waitcnt vmcnt(0)" ::: "memory"); grid.sync(); __builtin_amdgcn_fence(__ATOMIC_ACQUIRE, "agent"); asm volatile("s_waitcnt vmcnt(0)" ::: "memory"); } while (0)
__global__ void __launch_bounds__(512, 2) yoco_fwd(Params p) {
    extern __shared__ __attribute__((aligned(16))) unsigned char lds_raw[];
    LAS unsigned char* lds = (LAS unsigned char*)lds_raw;
    cg::grid_group grid = cg::this_grid();
    unsigned char* ws = p.ws;
    bf16_t* XN = (bf16_t*)(ws + WS_XN);
    float* HO = (float*)(ws + WS_HO);
    const int G = gridDim.x, bid = blockIdx.x;

#ifndef MK_DUMP
#define MK_DUMP 0
#endif
#ifndef MK_STOP
#define MK_STOP 16
#endif
#define IN(k) (p.ph_lo <= (k) && (k) < p.ph_hi)
#define BOTH(k) (IN(k) && IN((k) + 1))
    if (IN(0)) {
    tr_region(lds, p.w_in_a, NIN, 2048, 6144, p.g_norm_a, (bf16_t*)(ws + WS_WIN), 0, 0);
    tr_region(lds, p.w_out_a, 2048, 2048, 2048, nullptr, (bf16_t*)(ws + WS_WOUTA), 0, 0);
    tr_region(lds, p.w_ffn_gate, DFF, 2048, DFF, p.g_ffn_norm, (bf16_t*)(ws + WS_WF0), 1, 0);
    tr_region(lds, p.w_ffn_up, DFF, 2048, DFF, p.g_ffn_norm, (bf16_t*)(ws + WS_WF0), 2, 0);
    tr_region(lds, p.w_ffn_down, 2048, DFF, 2048, nullptr, (bf16_t*)(ws + WS_WD0), 0, 0);
    tr_region(lds, p.w_kv, 4096, 2048, 4096, p.g_kv_norm, (bf16_t*)(ws + WS_WKVQ), 0, 0);
    tr_region(lds, p.w_q_b, 2048, 2048, 2048, p.g_norm_b, (bf16_t*)(ws + WS_WKVQ), 0, 4096);
    tr_region(lds, p.w_o_b, 2048, 2048, 2048, nullptr, (bf16_t*)(ws + WS_WOB), 0, 0);
    tr_region(lds, p.w_ffn_gate + (size_t)2048 * DFF, DFF, 2048, DFF, p.g_ffn_norm + 2048, (bf16_t*)(ws + WS_WF1), 1, 0);
    tr_region(lds, p.w_ffn_up + (size_t)2048 * DFF, DFF, 2048, DFF, p.g_ffn_norm + 2048, (bf16_t*)(ws + WS_WF1), 2, 0);
    tr_region(lds, p.w_ffn_down + (size_t)DFF * 2048, 2048, DFF, 2048, nullptr, (bf16_t*)(ws + WS_WD1), 0, 0);
    norm_phase<true>(p, lds);
        if (BOTH(0)) GRID_SYNC();
    }
    if (IN(1)) {

    {
        pg8::Gemm g{XN, (const bf16_t*)(ws + WS_WIN), MTOT, 6144, 2048}; pg8::StaticOrder S; S.init(MTOT, 6144, G, bid);
        EpiIn E{(bf16_t*)(ws + WS_QA), (bf16_t*)(ws + WS_KA), (bf16_t*)(ws + WS_VTA), (bf16_t*)(ws + WS_GA), p.ph_hi > 0 ? 1.0f : 0.0f};
        pg8::gemm_phase<EpiIn, pg8::StaticOrder, true, true>(lds, g, S, E);
    }
        if (BOTH(1)) GRID_SYNC();
    }
    if (IN(2)) {
    gla_intra_phase(p, lds);
        if (BOTH(2)) GRID_SYNC();
    }
    if (IN(3)) {
    gla_scan_phase(p, lds);
        if (BOTH(3)) GRID_SYNC();
    }
    if (IN(4)) {
    gla_out_phase(p);
        if (BOTH(4)) GRID_SYNC();
    }
    if (IN(5)) {
    {
        pg8::Gemm g{XN, (const bf16_t*)(ws + WS_WOUTA), MTOT, 2048, 2048}; pg8::StaticOrder S; S.init(MTOT, 2048, G, bid);
        EpiRes<true, false> E{p, HO};
        pg8::gemm_phase<EpiRes<true, false>, pg8::StaticOrder, true, true>(lds, g, S, E);
    }
        if (BOTH(5)) GRID_SYNC();
    }
    if (IN(6)) {
    norm_phase<false>(p, lds);
        if (BOTH(6)) GRID_SYNC();
    }
    if (IN(7)) {
    {
        pg8::Gemm g{XN, (const bf16_t*)(ws + WS_WF0), MTOT, 2 * DFF, 2048}; pg8::StaticOrder S; S.init(MTOT, 2 * DFF, G, bid);
        EpiSwiglu E{(bf16_t*)(ws + WS_ACT)};
        pg8::gemm_phase<EpiSwiglu, pg8::StaticOrder, true, true>(lds, g, S, E);
    }
        if (BOTH(7)) GRID_SYNC();
    }
    if (IN(8)) {
    {
        pg8::Gemm g{(const bf16_t*)(ws + WS_ACT), (const bf16_t*)(ws + WS_WD0), MTOT, 2048, DFF}; pg8::StaticOrder S; S.init(MTOT, 2048, G, bid);
        EpiRes<false, false> E{p, HO};
        pg8::gemm_phase<EpiRes<false, false>, pg8::StaticOrder, true, true>(lds, g, S, E);
    }
        if (BOTH(8)) GRID_SYNC();
    }
    if (IN(9)) {
    norm_phase<false>(p, lds);
        if (BOTH(9)) GRID_SYNC();
    }
    if (IN(10)) {
    {
        pg8::Gemm g{XN, (const bf16_t*)(ws + WS_WKVQ), MTOT, 6144, 2048}; pg8::StaticOrder S; S.init(MTOT, 6144, G, bid);
        EpiKvq E{(bf16_t*)(ws + WS_KR), (bf16_t*)(ws + WS_VTB), (bf16_t*)(ws + WS_QR), p.ph_hi > 0 ? 1.0f : 0.0f};
        pg8::gemm_phase<EpiKvq, pg8::StaticOrder, true, true>(lds, g, S, E);
    }
        if (BOTH(10)) GRID_SYNC();
    }
    if (IN(11)) {
    knorm_phase(p);
        if (BOTH(11)) GRID_SYNC();
    }
    if (IN(12)) {
    attn_phase(p, lds);
        if (BOTH(12)) GRID_SYNC();
    }
    if (IN(13)) {
    {
        pg8::Gemm g{XN, (const bf16_t*)(ws + WS_WOB), MTOT, 2048, 2048}; pg8::StaticOrder S; S.init(MTOT, 2048, G, bid);
        EpiRes<false, false> E{p, HO};
        pg8::gemm_phase<EpiRes<false, false>, pg8::StaticOrder, true, true>(lds, g, S, E);
    }
        if (BOTH(13)) GRID_SYNC();
    }
    if (IN(14)) {
    norm_phase<false>(p, lds);
        if (BOTH(14)) GRID_SYNC();
    }
    if (IN(15)) {
    {
        pg8::Gemm g{XN, (const bf16_t*)(ws + WS_WF1), MTOT, 2 * DFF, 2048}; pg8::StaticOrder S; S.init(MTOT, 2 * DFF, G, bid);
        EpiSwiglu E{(bf16_t*)(ws + WS_ACT)};
        pg8::gemm_phase<EpiSwiglu, pg8::StaticOrder, true, true>(lds, g, S, E);
    }
        if (BOTH(15)) GRID_SYNC();
    }
    if (IN(16)) {
    {
        pg8::Gemm g{(const bf16_t*)(ws + WS_ACT), (const bf16_t*)(ws + WS_WD1), MTOT, 2048, DFF}; pg8::StaticOrder S; S.init(MTOT, 2048, G, bid);
        EpiRes<false, true> E{p, HO};
        pg8::gemm_phase<EpiRes<false, true>, pg8::StaticOrder, true, true>(lds, g, S, E);
    }
    }
    if (IN(17)) {
        const int gt = blockIdx.x * 512 + opaque_tid(), ngt = gridDim.x * 512;
        for (size_t i = gt; i < (size_t)BATCH * SEQ * DM; i += ngt) {
            const size_t row = i / DM, c = i - row * DM; const size_t b = row / SEQ, t = row - b * SEQ; const size_t src = (b * LTOT + OFFS + t) * DM + c;
            float v;
            if (MK_DUMP == 0) v = HO[src];
            else if (MK_DUMP == 1) v = bf_lo((unsigned)XN[src]);
            else v = bf_lo((unsigned)((const bf16_t*)(ws + WS_R + (size_t)(MK_DUMP - 2) * SZ_ROW1K))[i]);
            p.out[i] = v;
        }
    }
#undef IN
#undef BOTH
}

extern "C" void kernel_launch(void* const* d_in, const int* in_sizes, int n_in, void* d_out, int out_size, void* d_ws, size_t ws_size, hipStream_t stream) {
    static int grid = 0;
    if (grid == 0) {
        if (n_in != 19 || ws_size < WS_END) { fprintf(stderr, "kernel_launch: expected 19 inputs and >= %zu bytes of workspace; got %d, %zu\n", (size_t)WS_END, n_in, ws_size); grid = -1; return; }
        int dev = 0, cus = 0, per_cu = 0;
        hipGetDevice(&dev);
        hipDeviceGetAttribute(&cus, hipDeviceAttributeMultiprocessorCount, dev);
        if (hipFuncSetAttribute((const void*)yoco_fwd, hipFuncAttributeMaxDynamicSharedMemorySize, LDS_BYTES) != hipSuccess) { fprintf(stderr, "kernel_launch: hipFuncSetAttribute failed\n"); grid = -1; return; }
        if (hipOccupancyMaxActiveBlocksPerMultiprocessor(&per_cu, (const void*)yoco_fwd, 512, LDS_BYTES) != hipSuccess || per_cu < 1) { fprintf(stderr, "kernel_launch: occupancy query says %d\n", per_cu); per_cu = 1; }
        (void)hipGetLastError();
        grid = cus * 1;
    }
    if (grid < 0) return;
    Params p{};
    p.x = (const float*)d_in[0]; p.meta = (const float*)d_in[1]; p.g_norm_a = (const float*)d_in[2]; p.w_in_a = (const float*)d_in[3]; p.w_gate_up_a = (const float*)d_in[4];
    p.b_gate_a = (const float*)d_in[5]; p.g_onorm_a = (const float*)d_in[6]; p.w_out_a = (const float*)d_in[7]; p.g_kv_norm = (const float*)d_in[8]; p.w_kv = (const float*)d_in[9];
    p.g_k = (const float*)d_in[10]; p.g_norm_b = (const float*)d_in[11]; p.w_q_b = (const float*)d_in[12]; p.g_q_b = (const float*)d_in[13]; p.w_o_b = (const float*)d_in[14];
    p.g_ffn_norm = (const float*)d_in[15]; p.w_ffn_gate = (const float*)d_in[16]; p.w_ffn_up = (const float*)d_in[17]; p.w_ffn_down = (const float*)d_in[18];
    p.out = (float*)d_out; p.ws = (unsigned char*)d_ws;
#ifndef MK_SPLIT
#define MK_SPLIT 0
#endif
    constexpr int NPH = 17;
    if (MK_SPLIT) {
        for (int k0 = 0; k0 <= MK_STOP + (MK_STOP < 16 ? 1 : 0); ++k0) {
            const int k = k0 <= MK_STOP ? k0 : 17;
            p.ph_lo = k; p.ph_hi = k + 1;
            void* args[] = {&p};
            hipError_t e = hipLaunchCooperativeKernel((const void*)yoco_fwd, dim3(grid), dim3(512), args, LDS_BYTES, stream);
            if (e != hipSuccess) { fprintf(stderr, "kernel_launch: launch %d failed: %s (grid %d)\n", k, hipGetErrorString(e), grid); break; }
        }
    } else {
        p.ph_lo = 0; p.ph_hi = NPH;
        void* args[] = {&p};
        hipError_t e = hipLaunchCooperativeKernel((const void*)yoco_fwd, dim3(grid), dim3(512), args, LDS_BYTES, stream);
        if (e != hipSuccess) fprintf(stderr, "kernel_launch: cooperative launch failed: %s (grid %d)\n", hipGetErrorString(e), grid);
    }
}
```

```cpp
#include <hip/hip_runtime.h>
#include <hip/hip_cooperative_groups.h>
#include <cstdio>
#include <cstdint>
namespace cg = cooperative_groups;

#define LAS __attribute__((address_space(3)))
typedef unsigned short bf16_t;
typedef short bf16x8 __attribute__((ext_vector_type(8)));
typedef float f32x4 __attribute__((ext_vector_type(4)));
typedef float f32x16 __attribute__((ext_vector_type(16)));
typedef unsigned u32x4 __attribute__((ext_vector_type(4)));
typedef unsigned u32x2 __attribute__((ext_vector_type(2)));

constexpr int BATCH = 2, SEQ = 4096, LTOT = 4224, DM = 2048, MTOT = BATCH * LTOT;
constexpr int PADN = 112, OFFS = 128;
constexpr int DFF = 5632, NIN = 6160;
constexpr int GKD = 1024;
constexpr float EPS = 1e-6f;

constexpr size_t SZ_WIN = (size_t)6144 * 2048 * 2, SZ_SQ = (size_t)2048 * 2048 * 2, SZ_WF = (size_t)11264 * 2048 * 2, SZ_WD = (size_t)2048 * 5632 * 2;
constexpr size_t WS_WIN = 0, WS_WOUTA = WS_WIN + SZ_WIN, WS_WF0 = WS_WOUTA + SZ_SQ, WS_WD0 = WS_WF0 + SZ_WF;
constexpr size_t WS_WKVQ = WS_WD0 + SZ_WD, WS_WOB = WS_WKVQ + SZ_WIN, WS_WF1 = WS_WOB + SZ_SQ, WS_WD1 = WS_WF1 + SZ_WF;
constexpr size_t WS_XN = WS_WD1 + SZ_WD;
constexpr size_t SZ_ROW2K = (size_t)MTOT * 2048 * 2, SZ_ROW1K = (size_t)MTOT * 1024 * 2;
constexpr size_t WS_R = WS_XN + SZ_ROW2K;
constexpr size_t WS_QA = WS_R, WS_KA = WS_QA + SZ_ROW1K, WS_VTA = WS_KA + SZ_ROW1K, WS_GA = WS_VTA + SZ_ROW2K, WS_KST = WS_GA + SZ_ROW2K;
constexpr size_t WS_REND = WS_KST + SZ_ROW1K;
constexpr size_t WS_ACT = WS_R;
constexpr size_t WS_KR = WS_R, WS_QR = WS_KR + SZ_ROW2K, WS_VTB = WS_QR + SZ_ROW2K;
static_assert(WS_ACT + (size_t)MTOT * DFF * 2 <= WS_REND && WS_VTB + SZ_ROW2K <= WS_REND, "region");
constexpr size_t WS_HO = WS_REND;
constexpr size_t WS_AG = WS_HO + (size_t)MTOT * 2048 * 4;
constexpr size_t WS_DC = WS_AG + (size_t)MTOT * 16 * 4;
constexpr size_t WS_SSQ = WS_DC + (size_t)528 * 256 * 4;
constexpr size_t WS_SLAB = WS_SSQ + (size_t)MTOT * 32 * 4;
constexpr size_t WS_END = WS_SLAB + (size_t)11 * 256 * 2048 * 4;
constexpr size_t WS_BAR = WS_END;
constexpr size_t WS_TOTAL = WS_BAR + 16384;
constexpr size_t WS_OG = WS_QA;
constexpr size_t WS_OB = WS_WIN;
static_assert(WS_OB + SZ_ROW2K <= WS_WD0, "OB overlays layer-A weights only");

constexpr int LDS_BYTES = 155648;

typedef __bf16 bf16x2_t __attribute__((ext_vector_type(2)));
typedef float f32x2_t __attribute__((ext_vector_type(2)));
__device__ __forceinline__ unsigned cvt_pk_bf16_v(float lo, float hi) { const f32x2_t v = {lo, hi}; const bf16x2_t b = __builtin_convertvector(v, bf16x2_t); return __builtin_bit_cast(unsigned, b); }
__device__ __forceinline__ unsigned cvt_pk_bf16(float lo, float hi) { unsigned r; asm("v_cvt_pk_bf16_f32 %0, %1, %2" : "=v"(r) : "v"(lo), "v"(hi)); return r; }
__device__ __forceinline__ float bf_lo(unsigned u) { return __builtin_bit_cast(float, u << 16); }
__device__ __forceinline__ float bf_hi(unsigned u) { return __builtin_bit_cast(float, u & 0xffff0000u); }
__device__ __forceinline__ float wave_sum(float v) {
#pragma unroll
    for (int o = 1; o < 64; o <<= 1) v += __shfl_xor(v, o);
    return v;
}
__device__ __forceinline__ int opaque_tid() { int t = threadIdx.x; asm volatile("" : "+v"(t)); return t; }
__device__ __forceinline__ unsigned char* opaque_ptr(unsigned char* q) { asm volatile("" : "+s"(q)); return q; }
__device__ __forceinline__ float silu_f(float x) { return x * __builtin_amdgcn_rcpf(1.f + __expf(-x)); }
__device__ __forceinline__ float log_sigmoid_f(float x) { return fminf(x, 0.f) - __logf(1.f + __expf(-fabsf(x))); }

#define XB_TMO      128
#define XB_XCNT(j)  (256  + 64 * (j))
#define XB_XSUB(j)  (1280 + 64 * (j))
#define XB_XGEN(j)  (2304 + 64 * (j))
#define XB_TOP      3328
#define XB_TOPGEN   3392
#define XCD_BAR_WORDS 3456
#define XB_SPIN_CAP (1u << 20)
__device__ __forceinline__ unsigned xb_ld(unsigned* p)              { return __hip_atomic_load(p, __ATOMIC_RELAXED, __HIP_MEMORY_SCOPE_AGENT); }
__device__ __forceinline__ unsigned xb_add(unsigned* p, unsigned v) { return __hip_atomic_fetch_add(p, v, __ATOMIC_RELAXED, __HIP_MEMORY_SCOPE_AGENT); }
__device__ __forceinline__ unsigned xb_xcc_id() { return (unsigned)__builtin_amdgcn_s_getreg((3 << 11) | 20) & 0xFu; }
#define XB_SPIN(cond, bar) do { unsigned _sp = 0; while (cond) { __builtin_amdgcn_s_sleep(1); \
    if ((++_sp & 255u) == 0u) { if (xb_ld(&(bar)[XB_TMO])) break; if (_sp > XB_SPIN_CAP) { atomicAdd(&(bar)[XB_TMO], 1u); break; } } } } while (0)
struct XcdBarrier { unsigned* bar; unsigned x; volatile LAS unsigned* st; };
__device__ __forceinline__ XcdBarrier xcd_barrier_post(unsigned* bar, volatile LAS unsigned* st) {
    XcdBarrier b; b.bar = bar; b.x = xb_xcc_id(); b.st = st;
    if (threadIdx.x == 0) (void)xb_add(&bar[XB_XCNT(b.x)], 1u);
    return b;
}
__device__ __forceinline__ void xcd_barrier_complete(unsigned* bar, unsigned x, unsigned& nloc, unsigned& nx) {
    const unsigned G = gridDim.x * gridDim.y * gridDim.z;
    unsigned sum, cnt, mine, sp = 0u;
    for (;;) {
        sum = 0u; cnt = 0u; mine = 0u;
#pragma unroll
        for (unsigned j = 0; j < 16; ++j) { const unsigned c = xb_ld(&bar[XB_XCNT(j)]); sum += c; cnt += (c > 0u) ? 1u : 0u; mine = (j == x) ? c : mine; }
        if (sum == G) break;
        __builtin_amdgcn_s_sleep(1);
        if ((++sp & 255u) == 0u) { if (xb_ld(&bar[XB_TMO])) break; if (sp > XB_SPIN_CAP) { atomicAdd(&bar[XB_TMO], 1u); break; } }
    }
    nloc = mine > 0u ? mine : 1u; nx = cnt > 0u ? cnt : 1u;
}
__device__ __forceinline__ void xcd_barrier(const XcdBarrier& b) {
    asm volatile("s_waitcnt vmcnt(0)" ::: "memory");
    __syncthreads();
    if (threadIdx.x == 0) {
        unsigned* bar = b.bar;
        __builtin_amdgcn_s_waitcnt(0);
        unsigned nloc = b.st[0], nx = b.st[1];
        if (nloc == 0u) { xcd_barrier_complete(bar, b.x, nloc, nx); b.st[0] = nloc; b.st[1] = nx; }
        const unsigned old = xb_add(&bar[XB_XSUB(b.x)], 1u);
        const unsigned gen = old / nloc;
        if (old + 1u == (gen + 1u) * nloc) {
            __builtin_amdgcn_fence(__ATOMIC_RELEASE, "agent");
            asm volatile("s_waitcnt vmcnt(0)" ::: "memory");
            const unsigned og = xb_add(&bar[XB_TOP], 1u);
            const unsigned tg = og / nx;
            if (og + 1u == (tg + 1u) * nx) xb_add(&bar[XB_TOPGEN], 1u);
            else XB_SPIN(xb_ld(&bar[XB_TOPGEN]) == tg, bar);
            __builtin_amdgcn_fence(__ATOMIC_ACQUIRE, "agent");
            xb_add(&bar[XB_XGEN(b.x)], 1u);
            asm volatile("s_waitcnt vmcnt(0)" ::: "memory");
        } else {
            XB_SPIN(xb_ld(&bar[XB_XGEN(b.x)]) == gen, bar);
            __builtin_amdgcn_fence(__ATOMIC_ACQUIRE, "agent");
            asm volatile("s_waitcnt vmcnt(0)" ::: "memory");
        }
    }
    __syncthreads();
}


namespace pg8 {
constexpr int BM = 256, BK = 64, HALF = 128, HTB = HALF * BK * 2, NXCD = 8, WGM = 8;
__host__ __device__ __forceinline__ int lds_byte(int r, int c) { const int st = (r >> 4) * 2 + (c >> 5), rr = r & 15, cc = c & 31, ob = rr * 64 + cc * 2; return st * 1024 + (ob ^ (((ob >> 9) & 1) << 5)); }
__host__ __device__ __forceinline__ void stage_rc(int b, int& R, int& C) { const int st = b / 1024, sb = b % 1024, swz = sb ^ (((sb >> 9) & 1) << 5); R = (st >> 1) * 16 + swz / 64; C = (st & 1) * 32 + (swz % 64) / 2; }
__host__ __device__ __forceinline__ int perm32(int rho) { const int n = rho >> 4, i = rho & 15; return 8 * (i >> 2) + 4 * n + (i & 3); }
struct Unit { int pm, pn, kb, nt, split; };
struct Gemm { const bf16_t* A; const bf16_t* Bt; int M, N, K; };
struct StaticOrder {
    int nM, nN, nwg, G, c, ntf;
    __host__ __device__ void init(int M, int N, int K, int G_, int c_) { nM = M / BM; nN = N / BM; nwg = nM * nN; G = G_; c = c_; ntf = K / BK; }
    __host__ __device__ void map(long L, Unit& u) const {
        int wgid = (int)L; { const int q = nwg / NXCD, r = nwg % NXCD, xcd = wgid % NXCD, off = wgid / NXCD; wgid = (xcd < r ? xcd * (q + 1) : r * (q + 1) + (xcd - r) * q) + off; }
        const int nig = WGM * nN, gid = wgid / nig, fm = gid * WGM, gsz = (nM - fm) < WGM ? (nM - fm) : WGM;
        u.pm = fm + ((wgid % nig) % gsz); u.pn = (wgid % nig) / gsz; u.kb = 0; u.nt = ntf; u.split = 0;
    }
    __host__ __device__ bool next(int i, Unit& u) const { const long L = (long)i * G + c; if (L >= nwg) return false; map(L, u); return true; }
    __device__ __forceinline__ void a_ready(const Unit&) const {}
    __device__ __forceinline__ void done(const Unit&) const {}
};
struct TailOrder {
    StaticOrder so; int ntu, nun;
    __host__ __device__ void init(int N, int K, int G_, int c_, int nsplit) { so.init(8192, N, K, G_, c_); ntu = (K / BK) / nsplit; nun = so.nN * nsplit; }
    __host__ __device__ bool next(int i, Unit& u) const {
        const long L = (long)i * so.G + so.c;
        if (L < so.nwg) { so.map(L, u); return true; }
        const long j = L - so.nwg; if (j >= nun) return false;
        u.pm = so.nM; u.pn = (int)(j % so.nN); const int sidx = (int)(j / so.nN); u.kb = sidx * ntu * (BK * 2); u.nt = ntu; u.split = 1 + sidx; return true;
    }
    __device__ __forceinline__ void a_ready(const Unit&) const {}
    __device__ __forceinline__ void done(const Unit&) const {}
};
template <class Epi, class Sched, bool ALIGN_EPI = false, bool SP2 = false>
__device__ __forceinline__ void gemm_phase(LAS unsigned char* lds, const Gemm g, const Sched& S, const Epi& E) {
    const int tid = opaque_tid(), wid = __builtin_amdgcn_readfirstlane(tid >> 6), lane = tid & 63, wr = wid >> 2, wc = wid & 3, fr = lane & 15, fq = lane >> 4;
    const int K = g.K;
    unsigned voffA[2], voffB[2];
#pragma unroll
    for (int i = 0; i < 2; ++i) { int R, C; stage_rc(tid * 16 + i * 8192, R, C); const int Rb = Epi::PERM ? ((R & ~31) + perm32(R & 31)) : R;
        voffA[i] = (unsigned)(R * K + C) * 2u; voffB[i] = (unsigned)(Rb * K + C) * 2u; }
    const size_t kstep = (size_t)(BK * 2);
    const size_t hstep = (size_t)HALF * K * 2;
    const size_t tstep = 2 * hstep;
    const unsigned ldsw = (unsigned)wid * 1024u;
    const int aoff = lds_byte(wr * 64 + fr, fq * 8), boff = lds_byte(wc * 32 + fr, fq * 8);
#define PG8_SA(b, h) (((b) * 2 + (h)) * HTB)
#define PG8_SB(b, h) ((4 + (b) * 2 + (h)) * HTB)
#define PG8_STAGE(bufoff, gbase, voff) do { _Pragma("unroll") for (int _i = 0; _i < 2; ++_i) \
        __builtin_amdgcn_global_load_lds((const unsigned*)((const char*)(gbase) + (voff)[_i]), (LAS unsigned*)(lds + (bufoff) + ldsw + _i * 8192), 16, 0, 0); } while (0)
#define PG8_LDA(dst, b, h) do { _Pragma("unroll") for (int m = 0; m < 4; ++m) _Pragma("unroll") for (int k = 0; k < 2; ++k) dst[m][k] = *(const LAS bf16x8*)(lds + PG8_SA(b, h) + aoff + m * 2048 + k * 1024); } while (0)
#define PG8_LDB(dst, b, h) do { _Pragma("unroll") for (int n = 0; n < 2; ++n) _Pragma("unroll") for (int k = 0; k < 2; ++k) dst[n][k] = *(const LAS bf16x8*)(lds + PG8_SB(b, h) + boff + n * 2048 + k * 1024); } while (0)
#define PG8_MMA(ai, bj, At, Bt) do { __builtin_amdgcn_s_setprio(1); _Pragma("unroll") for (int m = 0; m < 4; ++m) _Pragma("unroll") for (int n = 0; n < 2; ++n) _Pragma("unroll") for (int k = 0; k < 2; ++k) \
        acc[ai][bj][m][n] = __builtin_amdgcn_mfma_f32_16x16x32_bf16(Bt[n][k], At[m][k], acc[ai][bj][m][n], 0, 0, 0); __builtin_amdgcn_s_setprio(0); } while (0)
#define PG8_WAIT_V(n) asm volatile("s_waitcnt vmcnt(" #n ")" ::: "memory")
#define PG8_WAIT_L(n) asm volatile("s_waitcnt lgkmcnt(" #n ")" ::: "memory")
#define PG8_BAR __builtin_amdgcn_s_barrier()
#define PG8_SCHED __builtin_amdgcn_sched_barrier(0)
    Unit cur, nxt; int ui = 0;
    if (!S.next(0, cur)) return;
    f32x4 acc[2][2][4][2];
#pragma unroll
    for (int a = 0; a < 2; ++a)
#pragma unroll
        for (int b = 0; b < 2; ++b)
#pragma unroll
            for (int m = 0; m < 4; ++m)
#pragma unroll
                for (int n = 0; n < 2; ++n) acc[a][b][m][n] = (f32x4){0.f, 0.f, 0.f, 0.f};
    bf16x8 At[4][2], B0[2][2], B1[2][2];
    const char* cA = (const char*)g.A + (size_t)cur.pm * tstep + cur.kb; const char* cB = (const char*)g.Bt + (size_t)cur.pn * tstep + cur.kb;
    S.a_ready(cur);
    if constexpr (SP2) {
        PG8_STAGE(PG8_SB(0, 0), cB, voffB); PG8_STAGE(PG8_SB(0, 1), cB + hstep, voffB); PG8_STAGE(PG8_SA(0, 0), cA, voffA); PG8_STAGE(PG8_SA(0, 1), cA + hstep, voffA);
        if (wr == 1) PG8_BAR;
        PG8_WAIT_V(2); PG8_BAR;
        PG8_STAGE(PG8_SB(1, 0), cB + kstep, voffB); PG8_STAGE(PG8_SA(1, 0), cA + kstep, voffA); PG8_STAGE(PG8_SB(1, 1), cB + hstep + kstep, voffB);
        PG8_WAIT_V(6); PG8_BAR;
    } else {
        PG8_STAGE(PG8_SB(0, 0), cB, voffB); PG8_STAGE(PG8_SA(0, 0), cA, voffA); PG8_STAGE(PG8_SB(0, 1), cB + hstep, voffB); PG8_STAGE(PG8_SA(0, 1), cA + hstep, voffA);
        if (wr == 1) PG8_BAR;
        PG8_WAIT_V(4); PG8_BAR;
        PG8_STAGE(PG8_SB(1, 0), cB + kstep, voffB); PG8_STAGE(PG8_SA(1, 0), cA + kstep, voffA); PG8_STAGE(PG8_SB(1, 1), cB + hstep + kstep, voffB);
        PG8_WAIT_V(6); PG8_BAR;
    }
    for (;;) {
        const bool has_next = S.next(ui + 1, nxt);
        const char* nA = has_next ? (const char*)g.A + (size_t)nxt.pm * tstep + nxt.kb : cA; const char* nB = has_next ? (const char*)g.Bt + (size_t)nxt.pn * tstep + nxt.kb : cB;
        const int nt = cur.nt;
        for (int t = 0; t < nt; t += 2) {
            const bool last = (t == nt - 2);
            const char* a1 = cA + (size_t)(t + 1) * kstep;
            const char* a2 = last ? nA : cA + (size_t)(t + 2) * kstep; const char* b2 = last ? nB : cB + (size_t)(t + 2) * kstep;
            const char* a3 = a2 + kstep; const char* b3 = b2 + kstep;
            if (last && has_next) S.a_ready(nxt);
            if constexpr (SP2) {
            PG8_LDB(B0, 0, 0); PG8_LDB(B1, 0, 1); PG8_SCHED; PG8_LDA(At, 0, 0); PG8_STAGE(PG8_SA(1, 1), a1 + hstep, voffA);
            PG8_WAIT_V(8); PG8_WAIT_L(0); PG8_BAR; PG8_MMA(0, 0, At, B0); PG8_MMA(0, 1, At, B1); PG8_BAR; PG8_SCHED;
            PG8_LDA(At, 0, 1); PG8_STAGE(PG8_SB(0, 0), b2, voffB); PG8_STAGE(PG8_SB(0, 1), b2 + hstep, voffB); PG8_STAGE(PG8_SA(0, 0), a2, voffA);
            PG8_WAIT_V(8); PG8_WAIT_L(0); PG8_BAR; PG8_MMA(1, 0, At, B0); PG8_MMA(1, 1, At, B1); PG8_BAR; PG8_SCHED;
            PG8_LDB(B0, 1, 0); PG8_LDB(B1, 1, 1); PG8_SCHED; PG8_LDA(At, 1, 0); PG8_STAGE(PG8_SA(0, 1), a2 + hstep, voffA);
            PG8_WAIT_V(8); PG8_WAIT_L(0); PG8_BAR; PG8_MMA(0, 0, At, B0); PG8_MMA(0, 1, At, B1); PG8_BAR; PG8_SCHED;
            PG8_LDA(At, 1, 1); PG8_STAGE(PG8_SB(1, 0), b3, voffB); PG8_STAGE(PG8_SB(1, 1), b3 + hstep, voffB); PG8_STAGE(PG8_SA(1, 0), a3, voffA);
            PG8_WAIT_V(8); PG8_WAIT_L(0); PG8_BAR; PG8_MMA(1, 0, At, B0); PG8_MMA(1, 1, At, B1); PG8_BAR; PG8_SCHED;
            } else {
            PG8_LDB(B0, 0, 0); PG8_SCHED; PG8_LDA(At, 0, 0); PG8_STAGE(PG8_SA(1, 1), a1 + hstep, voffA);
            PG8_WAIT_L(8); PG8_BAR; PG8_WAIT_L(0); PG8_MMA(0, 0, At, B0); PG8_BAR; PG8_SCHED;
            PG8_LDB(B1, 0, 1); PG8_STAGE(PG8_SB(0, 0), b2, voffB);
            PG8_BAR; PG8_WAIT_L(0); PG8_MMA(0, 1, At, B1); PG8_BAR;
            PG8_LDA(At, 0, 1); PG8_STAGE(PG8_SA(0, 0), a2, voffA);
            PG8_BAR; PG8_WAIT_L(0); PG8_MMA(1, 0, At, B0); PG8_BAR; PG8_SCHED;
            PG8_STAGE(PG8_SB(0, 1), b2 + hstep, voffB);
            PG8_WAIT_V(6); PG8_BAR; PG8_MMA(1, 1, At, B1); PG8_BAR;
            PG8_LDB(B0, 1, 0); PG8_SCHED; PG8_LDA(At, 1, 0); PG8_STAGE(PG8_SA(0, 1), a2 + hstep, voffA);
            PG8_WAIT_L(8); PG8_BAR; PG8_WAIT_L(0); PG8_MMA(0, 0, At, B0); PG8_BAR; PG8_SCHED;
            PG8_LDB(B1, 1, 1); PG8_STAGE(PG8_SB(1, 0), b3, voffB);
            PG8_BAR; PG8_WAIT_L(0); PG8_MMA(0, 1, At, B1); PG8_BAR;
            PG8_LDA(At, 1, 1); PG8_STAGE(PG8_SA(1, 0), a3, voffA);
            PG8_BAR; PG8_WAIT_L(0); PG8_MMA(1, 0, At, B0); PG8_BAR; PG8_SCHED;
            PG8_STAGE(PG8_SB(1, 1), b3 + hstep, voffB);
            PG8_WAIT_V(6); PG8_BAR; PG8_MMA(1, 1, At, B1); PG8_BAR;
            }
        }
        if constexpr (ALIGN_EPI) { if (wr == 0) PG8_BAR; }
        if constexpr (!Epi::AFTER_DRAIN) { E(acc, cur, wr, wc, fr, fq); S.done(cur); }
        if (!has_next) break;
#pragma unroll
        for (int a = 0; a < 2; ++a)
#pragma unroll
            for (int b = 0; b < 2; ++b)
#pragma unroll
                for (int m = 0; m < 4; ++m)
#pragma unroll
                    for (int n = 0; n < 2; ++n) acc[a][b][m][n] = (f32x4){0.f, 0.f, 0.f, 0.f};
        cur = nxt; cA = nA; cB = nB; ++ui;
        if constexpr (ALIGN_EPI) { if (wr == 1) PG8_BAR; }
    }
    PG8_WAIT_V(0);
    if constexpr (!ALIGN_EPI) { if (wr == 0) PG8_BAR; }
    PG8_BAR;
#undef PG8_SA
#undef PG8_SB
#undef PG8_STAGE
#undef PG8_LDA
#undef PG8_LDB
#undef PG8_MMA
#undef PG8_WAIT_V
#undef PG8_WAIT_L
#undef PG8_BAR
#undef PG8_SCHED
}
}

struct Params {
    const float *x, *meta, *g_norm_a, *w_in_a, *w_gate_up_a, *b_gate_a, *g_onorm_a, *w_out_a, *g_kv_norm, *w_kv, *g_k, *g_norm_b, *w_q_b, *g_q_b, *w_o_b,
        *g_ffn_norm, *w_ffn_gate, *w_ffn_up, *w_ffn_down;
    float* out;
    unsigned char* ws;
    int ph_lo, ph_hi;
};

__device__ __forceinline__ const float* h0_row(const Params& p, int r) {
    const int b = r >= LTOT ? 1 : 0, pos = r - b * LTOT;
    if (pos < PADN) return nullptr;
    if (pos < OFFS) return p.meta + (size_t)(pos - PADN) * DM;
    return p.x + ((size_t)b * SEQ + (pos - OFFS)) * DM;
}

struct EpiIn {
    static constexpr bool PERM = true, AFTER_DRAIN = false;
    bf16_t *QA, *KA, *VTA, *GA; float one;
    __device__ __forceinline__ void operator()(const f32x4 (&acc)[2][2][4][2], const pg8::Unit& u, int wr, int wc, int fr, int fq) const {
        const int pn = u.pn;
#pragma unroll
        for (int ai = 0; ai < 2; ++ai)
#pragma unroll
            for (int m = 0; m < 4; ++m) {
                const int r = u.pm * 256 + ai * 128 + wr * 64 + m * 16 + fr;
#pragma unroll
                for (int bj = 0; bj < 2; ++bj) {
                    const int c = pn * 256 + bj * 128 + wc * 32 + fq * 8;
                    const f32x4 v0 = acc[ai][bj][m][0] * one, v1 = acc[ai][bj][m][1] * one;
                    if (pn < 4) {
                        const float sc = 0.0625f;
                        u32x4 w = {cvt_pk_bf16(v0[0] * sc, v0[1] * sc), cvt_pk_bf16(v0[2] * sc, v0[3] * sc), cvt_pk_bf16(v1[0] * sc, v1[1] * sc), cvt_pk_bf16(v1[2] * sc, v1[3] * sc)};
                        *(u32x4*)(QA + (size_t)r * GKD + c) = w;
                    } else if (pn < 8) {
                        u32x4 w = {cvt_pk_bf16(v0[0], v0[1]), cvt_pk_bf16(v0[2], v0[3]), cvt_pk_bf16(v1[0], v1[1]), cvt_pk_bf16(v1[2], v1[3])};
                        *(u32x4*)(KA + (size_t)r * GKD + (c - 1024)) = w;
                    } else if (pn < 16) {
                        const int cv = c - 2048, hh = cv >> 9, dv = cv & 511;
                        const int b = r >= LTOT ? 1 : 0, pos = r - b * LTOT;
                        bf16_t* dst = VTA + ((size_t)((b * 4 + hh) * 512 + dv)) * LTOT + pos;
                        const unsigned w0 = cvt_pk_bf16(v0[0], v0[1]), w1 = cvt_pk_bf16(v0[2], v0[3]), w2 = cvt_pk_bf16(v1[0], v1[1]), w3 = cvt_pk_bf16(v1[2], v1[3]);
                        dst[0] = (bf16_t)w0; dst[(size_t)LTOT] = (bf16_t)(w0 >> 16); dst[(size_t)2 * LTOT] = (bf16_t)w1; dst[(size_t)3 * LTOT] = (bf16_t)(w1 >> 16);
                        dst[(size_t)4 * LTOT] = (bf16_t)w2; dst[(size_t)5 * LTOT] = (bf16_t)(w2 >> 16); dst[(size_t)6 * LTOT] = (bf16_t)w3; dst[(size_t)7 * LTOT] = (bf16_t)(w3 >> 16);
                    } else {
                        u32x4 w = {cvt_pk_bf16(silu_f(v0[0]), silu_f(v0[1])), cvt_pk_bf16(silu_f(v0[2]), silu_f(v0[3])), cvt_pk_bf16(silu_f(v1[0]), silu_f(v1[1])), cvt_pk_bf16(silu_f(v1[2]), silu_f(v1[3]))};
                        *(u32x4*)(GA + (size_t)r * DM + (c - 4096)) = w;
                    }
                }
            }
    }
};
struct EpiKvq {
    static constexpr bool PERM = true, AFTER_DRAIN = false;
    bf16_t *KR, *VTB, *QR; const float* SSQ;
    __device__ __forceinline__ void operator()(const f32x4 (&acc)[2][2][4][2], const pg8::Unit& u, int wr, int wc, int fr, int fq) const {
        const int pn = u.pn;
#pragma unroll
        for (int ai = 0; ai < 2; ++ai)
#pragma unroll
            for (int m = 0; m < 4; ++m) {
                const int r = u.pm * 256 + ai * 128 + wr * 64 + m * 16 + fr;
                float rsv;
                { const f32x4 a = *(const f32x4*)(SSQ + (size_t)r * 32 + fq * 8), b = *(const f32x4*)(SSQ + (size_t)r * 32 + fq * 8 + 4);
                  float t = ((a[0] + a[1]) + (a[2] + a[3])) + ((b[0] + b[1]) + (b[2] + b[3]));
                  t += __shfl_xor(t, 16); t += __shfl_xor(t, 32);
                  rsv = rsqrtf(t * (1.f / DM) + EPS); }
#pragma unroll
                for (int bj = 0; bj < 2; ++bj) {
                    const int c = pn * 256 + bj * 128 + wc * 32 + fq * 8;
                    const f32x4 v0 = acc[ai][bj][m][0] * rsv, v1 = acc[ai][bj][m][1] * rsv;
                    const unsigned w0 = cvt_pk_bf16(v0[0], v0[1]), w1 = cvt_pk_bf16(v0[2], v0[3]), w2 = cvt_pk_bf16(v1[0], v1[1]), w3 = cvt_pk_bf16(v1[2], v1[3]);
                    if (pn < 8) {
                        u32x4 w = {w0, w1, w2, w3};
                        *(u32x4*)(KR + (size_t)r * DM + c) = w;
                    } else if (pn < 16) {
                        const int cv = c - 2048, hh = cv >> 7, dv = cv & 127;
                        const int b = r >= LTOT ? 1 : 0, pos = r - b * LTOT;
                        bf16_t* dst = VTB + ((size_t)((b * 16 + hh) * 128 + dv)) * LTOT + pos;
                        dst[0] = (bf16_t)w0; dst[(size_t)LTOT] = (bf16_t)(w0 >> 16); dst[(size_t)2 * LTOT] = (bf16_t)w1; dst[(size_t)3 * LTOT] = (bf16_t)(w1 >> 16);
                        dst[(size_t)4 * LTOT] = (bf16_t)w2; dst[(size_t)5 * LTOT] = (bf16_t)(w2 >> 16); dst[(size_t)6 * LTOT] = (bf16_t)w3; dst[(size_t)7 * LTOT] = (bf16_t)(w3 >> 16);
                    } else {
                        u32x4 w = {w0, w1, w2, w3};
                        *(u32x4*)(QR + (size_t)r * DM + (c - 4096)) = w;
                    }
                }
            }
    }
};
struct EpiSwiglu {
    static constexpr bool PERM = true, AFTER_DRAIN = false;
    bf16_t* ACT; const float* SSQ;
    __device__ __forceinline__ void operator()(const f32x4 (&acc)[2][2][4][2], const pg8::Unit& u, int wr, int wc, int fr, int fq) const {
#pragma unroll
        for (int ai = 0; ai < 2; ++ai)
#pragma unroll
            for (int m = 0; m < 4; ++m) {
                const int r = u.pm * 256 + ai * 128 + wr * 64 + m * 16 + fr;
                float rsv;
                { const f32x4 a = *(const f32x4*)(SSQ + (size_t)r * 32 + fq * 8), b = *(const f32x4*)(SSQ + (size_t)r * 32 + fq * 8 + 4);
                  float t = ((a[0] + a[1]) + (a[2] + a[3])) + ((b[0] + b[1]) + (b[2] + b[3]));
                  t += __shfl_xor(t, 16); t += __shfl_xor(t, 32);
                  rsv = rsqrtf(t * (1.f / DM) + EPS); }
                const int c = u.pn * 128 + wc * 32 + fq * 8;
                const f32x4 g0 = acc[ai][0][m][0] * rsv, g1 = acc[ai][0][m][1] * rsv, u0 = acc[ai][1][m][0] * rsv, u1 = acc[ai][1][m][1] * rsv;
                u32x4 w = {cvt_pk_bf16(silu_f(g0[0]) * u0[0], silu_f(g0[1]) * u0[1]), cvt_pk_bf16(silu_f(g0[2]) * u0[2], silu_f(g0[3]) * u0[3]),
                           cvt_pk_bf16(silu_f(g1[0]) * u1[0], silu_f(g1[1]) * u1[1]), cvt_pk_bf16(silu_f(g1[2]) * u1[2], silu_f(g1[3]) * u1[3])};
                *(u32x4*)(ACT + (size_t)r * DFF + c) = w;
            }
    }
};
template <bool SRC0, bool FINAL, bool WXN>
struct EpiRes {
    static constexpr bool PERM = true, AFTER_DRAIN = false;
    const float *x, *meta; float *out, *HO; bf16_t* XN; float *SSQ, *SLAB;
    __device__ __forceinline__ void operator()(const f32x4 (&acc)[2][2][4][2], const pg8::Unit& u, int wr, int wc, int fr, int fq) const {
        if (u.split) {
            char* slab = (char*)SLAB + (size_t)(u.split - 1) * 256 * DM * 4;
#pragma unroll
            for (int ai = 0; ai < 2; ++ai)
#pragma unroll
                for (int m = 0; m < 4; ++m) {
                    const int rl = ai * 128 + wr * 64 + m * 16 + fr;
#pragma unroll
                    for (int bj = 0; bj < 2; ++bj) {
                        const unsigned bo = ((unsigned)rl * DM + (unsigned)(u.pn * 256 + bj * 128 + wc * 32 + fq * 8)) * 4u;
                        *(f32x4*)(slab + bo) = acc[ai][bj][m][0]; *(f32x4*)(slab + bo + 16) = acc[ai][bj][m][1];
                    }
                }
            return;
        }
#pragma unroll
        for (int ai = 0; ai < 2; ++ai) {
            f32x4 res0[4][2], res1[4][2];
#pragma unroll
            for (int m = 0; m < 4; ++m) {
                const int r = u.pm * 256 + ai * 128 + wr * 64 + m * 16 + fr;
                const int b = r >= LTOT ? 1 : 0, pos = r - b * LTOT;
                const unsigned c0 = (unsigned)(u.pn * 256 + wc * 32 + fq * 8);
                const unsigned eh = (unsigned)r * DM + c0;
                const unsigned eo = ((unsigned)(b * SEQ + (pos - OFFS))) * DM + c0;
#pragma unroll
                for (int bj = 0; bj < 2; ++bj) {
                    f32x4 r0 = {0.f, 0.f, 0.f, 0.f}, r1 = {0.f, 0.f, 0.f, 0.f};
                    if (SRC0) {
                        if (pos >= OFFS) { r0 = *(const f32x4*)((const char*)x + (eo + bj * 128) * 4u); r1 = *(const f32x4*)((const char*)x + (eo + bj * 128) * 4u + 16); }
                        else if (pos >= PADN) { const unsigned em = ((unsigned)(pos - PADN) * DM + c0 + bj * 128) * 4u; r0 = *(const f32x4*)((const char*)meta + em); r1 = *(const f32x4*)((const char*)meta + em + 16); }
                    } else { r0 = *(const f32x4*)((const char*)HO + (eh + bj * 128) * 4u); r1 = *(const f32x4*)((const char*)HO + (eh + bj * 128) * 4u + 16); }
                    res0[m][bj] = r0; res1[m][bj] = r1;
                }
            }
#pragma unroll
            for (int m = 0; m < 4; ++m) {
                const int r = u.pm * 256 + ai * 128 + wr * 64 + m * 16 + fr;
                const int b = r >= LTOT ? 1 : 0, pos = r - b * LTOT;
                const unsigned c0 = (unsigned)(u.pn * 256 + wc * 32 + fq * 8);
                const unsigned eh = (unsigned)r * DM + c0;
                const unsigned eo = ((unsigned)(b * SEQ + (pos - OFFS))) * DM + c0;
                float ss = 0.f;
#pragma unroll
                for (int bj = 0; bj < 2; ++bj) {
                    f32x4 r0 = res0[m][bj], r1 = res1[m][bj];
                    r0 += acc[ai][bj][m][0]; r1 += acc[ai][bj][m][1];
                    if (FINAL) { if (pos >= OFFS) { *(f32x4*)((char*)out + (eo + bj * 128) * 4u) = r0; *(f32x4*)((char*)out + (eo + bj * 128) * 4u + 16) = r1; } }
                    else { *(f32x4*)((char*)HO + (eh + bj * 128) * 4u) = r0; *(f32x4*)((char*)HO + (eh + bj * 128) * 4u + 16) = r1; }
                    if (WXN) {
                        ss += ((r0[0] * r0[0] + r0[1] * r0[1]) + (r0[2] * r0[2] + r0[3] * r0[3])) + ((r1[0] * r1[0] + r1[1] * r1[1]) + (r1[2] * r1[2] + r1[3] * r1[3]));
                        const u32x4 w = {cvt_pk_bf16(r0[0], r0[1]), cvt_pk_bf16(r0[2], r0[3]), cvt_pk_bf16(r1[0], r1[1]), cvt_pk_bf16(r1[2], r1[3])};
                        *(u32x4*)((char*)XN + (eh + bj * 128) * 2u) = w;
                    }
                }
                if (WXN) { ss += __shfl_xor(ss, 16); ss += __shfl_xor(ss, 32); if (fq == 0) *(float*)((char*)SSQ + ((unsigned)r * 32 + u.pn * 4 + wc) * 4u) = ss; }
            }
        }
    }
};

template <bool SRC0, bool FINAL>
__device__ __forceinline__ void tail_fix_phase(const Params& p, int nsplit) {
    const int tid = opaque_tid(), lane = tid & 63, wave = tid >> 6;
    float* HO = (float*)(p.ws + WS_HO); bf16_t* XN = (bf16_t*)(p.ws + WS_XN); float* SSQ = (float*)(p.ws + WS_SSQ); const float* SLAB = (const float*)(p.ws + WS_SLAB);
    for (int rr = blockIdx.x; rr < 256; rr += gridDim.x) {
        const int r = 8192 + rr, cols = wave * 256 + lane * 4;
        const float* src = SRC0 ? h0_row(p, r) : HO + (size_t)r * DM;
        f32x4 v = src ? *(const f32x4*)(src + cols) : (f32x4){0.f, 0.f, 0.f, 0.f};
        for (int sidx = 0; sidx < nsplit; ++sidx) v += *(const f32x4*)(SLAB + ((size_t)sidx * 256 + rr) * DM + cols);
        if (FINAL) {
            const int pos = r - LTOT;
            *(f32x4*)(p.out + ((size_t)SEQ + (pos - OFFS)) * DM + cols) = v;
        } else {
            *(f32x4*)(HO + (size_t)r * DM + cols) = v;
            const u32x2 w = {cvt_pk_bf16(v[0], v[1]), cvt_pk_bf16(v[2], v[3])};
            *(u32x2*)(XN + (size_t)r * DM + cols) = w;
            const float ss = wave_sum((v[0] * v[0] + v[1] * v[1]) + (v[2] * v[2] + v[3] * v[3]));
            if (lane == 0) SSQ[(size_t)r * 32 + wave] = ss;
            if (wave == 0 && lane < 24) SSQ[(size_t)r * 32 + 8 + lane] = 0.f;
        }
    }
}

__device__ __forceinline__ void tr_region(LAS unsigned char* lds, const float* __restrict__ W, int pitch, int K, int ncols, const float* __restrict__ gain, bf16_t* dst, int mode, int row_off, int first, int stride) {
    const int tid = opaque_tid();
    const int nN = ncols >> 8, nK = K >> 6, ntl = nN * nK;
    LAS bf16_t* tile = (LAS bf16_t*)lds;
    const int n4 = tid & 63, kq = tid >> 6;
    f32x4 v[8], vn[8];
#define TR_LOAD(dstv, tt) do { const int _kt = (tt) / nN, _nt = (tt) - _kt * nN; \
        _Pragma("unroll") for (int i = 0; i < 8; ++i) dstv[i] = __builtin_nontemporal_load((const f32x4*)(W + (size_t)((_kt << 6) + kq * 8 + i) * pitch + (_nt << 8) + 4 * n4)); } while (0)
    int t = first;
    if (t < ntl) TR_LOAD(v, t);
    for (; t < ntl; t += stride) {
        const int kt = t / nN, ntile = t - kt * nN, k0 = kt << 6, n0 = ntile << 8;
        if (t + stride < ntl) TR_LOAD(vn, t + stride);
        if (gain) {
#pragma unroll
            for (int i = 0; i < 8; ++i) v[i] = v[i] * gain[k0 + kq * 8 + i];
        }
#pragma unroll
        for (int j = 0; j < 4; ++j) {
            const u32x4 o = {cvt_pk_bf16(v[0][j], v[1][j]), cvt_pk_bf16(v[2][j], v[3][j]), cvt_pk_bf16(v[4][j], v[5][j]), cvt_pk_bf16(v[6][j], v[7][j])};
            *(LAS u32x4*)(tile + (4 * n4 + j) * 72 + kq * 8) = o;
        }
        __syncthreads();
#pragma unroll
        for (int i = 0; i < 4; ++i) {
            const int q = tid + 512 * i, n = q >> 3, ch = q & 7;
            const u32x4 o = *(LAS u32x4*)(tile + n * 72 + ch * 8);
            const int nn = n0 + n;
            const int row = mode == 0 ? row_off + nn : ((nn >> 7) * 256 + (mode == 2 ? 128 : 0) + (nn & 127));
            *(u32x4*)(dst + (size_t)row * K + k0 + ch * 8) = o;
        }
        __syncthreads();
#pragma unroll
        for (int i = 0; i < 8; ++i) v[i] = vn[i];
    }
#undef TR_LOAD
}
__device__ __forceinline__ void tr_deferred(const Params& p, LAS unsigned char* lds, int first, int stride, int groups) {
    unsigned char* ws = p.ws;
    if (groups & 1) {
        tr_region(lds, p.w_out_a, 2048, 2048, 2048, nullptr, (bf16_t*)(ws + WS_WOUTA), 0, 0, first, stride);
        tr_region(lds, p.w_ffn_gate, DFF, 2048, DFF, p.g_ffn_norm, (bf16_t*)(ws + WS_WF0), 1, 0, first, stride);
        tr_region(lds, p.w_ffn_up, DFF, 2048, DFF, p.g_ffn_norm, (bf16_t*)(ws + WS_WF0), 2, 0, first, stride);
        tr_region(lds, p.w_ffn_down, 2048, DFF, 2048, nullptr, (bf16_t*)(ws + WS_WD0), 0, 0, first, stride);
    }
    if (groups & 2) {
        tr_region(lds, p.w_kv, 4096, 2048, 4096, p.g_kv_norm, (bf16_t*)(ws + WS_WKVQ), 0, 0, first, stride);
        tr_region(lds, p.w_q_b, 2048, 2048, 2048, p.g_norm_b, (bf16_t*)(ws + WS_WKVQ), 0, 4096, first, stride);
        tr_region(lds, p.w_o_b, 2048, 2048, 2048, nullptr, (bf16_t*)(ws + WS_WOB), 0, 0, first, stride);
    }
    if (groups & 4) {
        tr_region(lds, p.w_ffn_gate + (size_t)2048 * DFF, DFF, 2048, DFF, p.g_ffn_norm + 2048, (bf16_t*)(ws + WS_WF1), 1, 0, first, stride);
        tr_region(lds, p.w_ffn_up + (size_t)2048 * DFF, DFF, 2048, DFF, p.g_ffn_norm + 2048, (bf16_t*)(ws + WS_WF1), 2, 0, first, stride);
        tr_region(lds, p.w_ffn_down + (size_t)DFF * 2048, 2048, DFF, 2048, nullptr, (bf16_t*)(ws + WS_WD1), 0, 0, first, stride);
    }
}

template <bool FIRST>
__device__ __forceinline__ void norm_phase(const Params& p, LAS unsigned char* lds) {
    const int tid = opaque_tid(), lane = tid & 63, wave = tid >> 6;
    bf16_t* XN = (bf16_t*)(p.ws + WS_XN);
    const float* HO = (const float*)(p.ws + WS_HO);
    float* AG = (float*)(p.ws + WS_AG);
    LAS float* wl = (LAS float*)lds;
    if (FIRST) {
        for (int e = tid; e < 2048 * 16; e += 512) { const int k = e >> 4, j = e & 15; wl[j * 2048 + k] = p.g_norm_a[k] * p.w_in_a[(size_t)k * NIN + 6144 + j]; }
        __syncthreads();
    }
    const int gw = blockIdx.x * 8 + wave, ngw = gridDim.x * 8;
    for (int r = gw; r < MTOT; r += ngw) {
        const float* src = FIRST ? h0_row(p, r) : HO + (size_t)r * DM;
        f32x4 v[8];
        float ss = 0.f;
#pragma unroll
        for (int j = 0; j < 8; ++j) {
            v[j] = src ? ((const f32x4*)src)[lane + 64 * j] : (f32x4){0.f, 0.f, 0.f, 0.f};
            ss += (v[j][0] * v[j][0] + v[j][1] * v[j][1]) + (v[j][2] * v[j][2] + v[j][3] * v[j][3]);
        }
        const float rstd = rsqrtf(wave_sum(ss) * (1.f / DM) + EPS);
#pragma unroll
        for (int j = 0; j < 8; ++j) {
            v[j] = v[j] * rstd;
            u32x2 o = {cvt_pk_bf16(v[j][0], v[j][1]), cvt_pk_bf16(v[j][2], v[j][3])};
            ((u32x2*)(XN + (size_t)r * DM))[lane + 64 * j] = o;
        }
        if (FIRST) {
            float a16[16];
#pragma unroll
            for (int jj = 0; jj < 16; ++jj) {
                float a = 0.f;
#pragma unroll
                for (int j = 0; j < 8; ++j) { const f32x4 w4 = *(const LAS f32x4*)(wl + jj * 2048 + 4 * (lane + 64 * j)); a += (v[j][0] * w4[0] + v[j][1] * w4[1]) + (v[j][2] * w4[2] + v[j][3] * w4[3]); }
                a16[jj] = a;
            }
            float b8[8], c4[4], d2[2];
            const bool h32 = lane & 32, h16 = lane & 16, h8 = lane & 8, h4 = lane & 4;
#pragma unroll
            for (int j = 0; j < 8; ++j) { const float mine = h32 ? a16[j + 8] : a16[j], other = h32 ? a16[j] : a16[j + 8]; b8[j] = mine + __shfl_xor(other, 32); }
#pragma unroll
            for (int j = 0; j < 4; ++j) { const float mine = h16 ? b8[j + 4] : b8[j], other = h16 ? b8[j] : b8[j + 4]; c4[j] = mine + __shfl_xor(other, 16); }
#pragma unroll
            for (int j = 0; j < 2; ++j) { const float mine = h8 ? c4[j + 2] : c4[j], other = h8 ? c4[j] : c4[j + 2]; d2[j] = mine + __shfl_xor(other, 8); }
            float e1 = (h4 ? d2[1] : d2[0]) + __shfl_xor(h4 ? d2[0] : d2[1], 4);
            e1 += __shfl_xor(e1, 2); e1 += __shfl_xor(e1, 1);
            if ((lane & 3) == 0) AG[(size_t)r * 16 + (lane >> 2)] = e1;
        }
    }
}

__device__ __forceinline__ void knorm_phase(const Params& p) {
    const int tid = opaque_tid(), lane = tid & 63, wave = tid >> 6;
    bf16_t* KR = (bf16_t*)(p.ws + WS_KR);
    const int gw = blockIdx.x * 8 + wave, ngw = gridDim.x * 8;
    for (int r = gw; r < MTOT; r += ngw) {
#pragma unroll
        for (int i = 0; i < 4; ++i) {
            const int ch = lane + 64 * i;
            u32x4 w = ((const u32x4*)(KR + (size_t)r * DM))[ch];
            float f[8] = {bf_lo(w[0]), bf_hi(w[0]), bf_lo(w[1]), bf_hi(w[1]), bf_lo(w[2]), bf_hi(w[2]), bf_lo(w[3]), bf_hi(w[3])};
            float ss = 0.f;
#pragma unroll
            for (int e = 0; e < 8; ++e) ss += f[e] * f[e];
            ss += __shfl_xor(ss, 1); ss += __shfl_xor(ss, 2); ss += __shfl_xor(ss, 4); ss += __shfl_xor(ss, 8);
            const float rstd = rsqrtf(ss * (1.f / 128.f) + EPS);
            const int d0 = (ch & 15) * 8;
            const f32x4 ga = *(const f32x4*)(p.g_k + d0), gb = *(const f32x4*)(p.g_k + d0 + 4);
            u32x4 o = {cvt_pk_bf16(f[0] * rstd * ga[0], f[1] * rstd * ga[1]), cvt_pk_bf16(f[2] * rstd * ga[2], f[3] * rstd * ga[3]),
                       cvt_pk_bf16(f[4] * rstd * gb[0], f[5] * rstd * gb[1]), cvt_pk_bf16(f[6] * rstd * gb[2], f[7] * rstd * gb[3])};
            ((u32x4*)(KR + (size_t)r * DM))[ch] = o;
        }
    }
}

__device__ __forceinline__ void gla_intra_phase(const Params& p, LAS unsigned char* lds, int u_first, int u_end, int u_stride) {
    const int tid = opaque_tid(), lane = tid & 63, wave = __builtin_amdgcn_readfirstlane(tid >> 6), fr = lane & 15, fq = lane >> 4;
    bf16_t* QA = (bf16_t*)(p.ws + WS_QA); const bf16_t* KA = (const bf16_t*)(p.ws + WS_KA); const bf16_t* VTA = (const bf16_t*)(p.ws + WS_VTA);
    bf16_t* KST = (bf16_t*)(p.ws + WS_KST); float* HO = (float*)(p.ws + WS_HO); float* DCB = (float*)(p.ws + WS_DC); const float* AG = (const float*)(p.ws + WS_AG);
    constexpr int OPS = 264;
    LAS bf16_t* QLO = (LAS bf16_t*)lds; LAS bf16_t* KLO = QLO + 64 * OPS; LAS bf16_t* QUP = KLO + 64 * OPS; LAS bf16_t* KUP = QUP + 64 * OPS;
    LAS bf16_t* PS = KUP + 64 * OPS;
    LAS bf16_t* VT = (LAS bf16_t*)lds;
    LAS float* PART = (LAS float*)(lds + 144384);
    for (int u = u_first; u < u_end; u += u_stride) {
        const int b = u / 264, rem = u - b * 264, c = rem >> 2, h = rem & 3;
        const int r0 = b * LTOT + c * 64;
        {
            const int dp = tid & 127, rq = __builtin_amdgcn_readfirstlane(tid >> 7), dcol = h * 256 + 2 * dp;
            float w0[16], w1[16];
#pragma unroll
            for (int rr = 0; rr < 16; ++rr) { const f32x2_t t = *(const f32x2_t*)(p.w_gate_up_a + rr * GKD + dcol); w0[rr] = t[0]; w1[rr] = t[1]; }
            const f32x2_t bg = *(const f32x2_t*)(p.b_gate_a + dcol);
            float bc0[16], bc1[16]; float run0 = 0.f, run1 = 0.f;
#pragma unroll
            for (int sI = 0; sI < 16; ++sI) {
                const float* ar = AG + (size_t)(r0 + rq * 16 + sI) * 16;
                float x0 = bg[0], x1 = bg[1];
#pragma unroll
                for (int rr = 0; rr < 16; ++rr) { const float av = ar[rr]; x0 += av * w0[rr]; x1 += av * w1[rr]; }
                run0 += log_sigmoid_f(x0) * 0.0625f; run1 += log_sigmoid_f(x1) * 0.0625f;
                bc0[sI] = run0; bc1[sI] = run1;
            }
            *(LAS f32x2_t*)(PART + rq * 256 + 2 * dp) = (f32x2_t){run0, run1};
            __syncthreads();
            const f32x2_t t0 = *(const LAS f32x2_t*)(PART + 2 * dp), t1 = *(const LAS f32x2_t*)(PART + 256 + 2 * dp), t2 = *(const LAS f32x2_t*)(PART + 512 + 2 * dp), t3 = *(const LAS f32x2_t*)(PART + 768 + 2 * dp);
            const float ref0 = t0[0] + t1[0], ref1 = t0[1] + t1[1];
            const float bl0 = ref0 + t2[0] + t3[0], bl1 = ref1 + t2[1] + t3[1];
            const float pre0 = (rq > 0 ? t0[0] : 0.f) + (rq > 1 ? t1[0] : 0.f) + (rq > 2 ? t2[0] : 0.f);
            const float pre1 = (rq > 0 ? t0[1] : 0.f) + (rq > 1 ? t1[1] : 0.f) + (rq > 2 ? t2[1] : 0.f);
            unsigned kst0[8], kst1[8];
#pragma unroll
            for (int sI = 0; sI < 16; ++sI) {
                const int rl = rq * 16 + sI;
                const size_t gofs = (size_t)(r0 + rl) * GKD + dcol;
                const unsigned qraw = *(const unsigned*)(QA + gofs), kraw = *(const unsigned*)(KA + gofs);
                const float q0 = bf_lo(qraw), q1 = bf_hi(qraw), k0 = bf_lo(kraw), k1 = bf_hi(kraw);
                const float v0 = bc0[sI] + pre0, v1 = bc1[sI] + pre1;
                const float e10 = __expf(v0 - ref0), e11 = __expf(v1 - ref1), e20 = __expf(ref0 - v0), e21 = __expf(ref1 - v1);
                *(LAS unsigned*)(QLO + rl * OPS + 2 * dp) = cvt_pk_bf16_v(q0 * e10, q1 * e11);
                *(LAS unsigned*)(KUP + rl * OPS + 2 * dp) = cvt_pk_bf16_v(k0 * e10, k1 * e11);
                *(LAS unsigned*)(QUP + rl * OPS + 2 * dp) = cvt_pk_bf16_v(q0 * e20, q1 * e21);
                *(LAS unsigned*)(KLO + rl * OPS + 2 * dp) = cvt_pk_bf16_v(k0 * e20, k1 * e21);
                *(unsigned*)(QA + gofs) = cvt_pk_bf16_v(q0 * __expf(v0), q1 * __expf(v1));
                const float ks0 = k0 * __expf(bl0 - v0), ks1 = k1 * __expf(bl1 - v1);
                if (sI & 1) { kst0[sI >> 1] = cvt_pk_bf16_v(bf_lo(kst0[sI >> 1]), ks0); kst1[sI >> 1] = cvt_pk_bf16_v(bf_lo(kst1[sI >> 1]), ks1); }
                else { kst0[sI >> 1] = cvt_pk_bf16_v(ks0, 0.f); kst1[sI >> 1] = cvt_pk_bf16_v(ks1, 0.f); }
            }
            bf16_t* kd = KST + (size_t)u * 16384 + (size_t)(2 * dp) * 64 + rq * 16;
            *(u32x4*)(kd) = (u32x4){kst0[0], kst0[1], kst0[2], kst0[3]}; *(u32x4*)(kd + 8) = (u32x4){kst0[4], kst0[5], kst0[6], kst0[7]};
            *(u32x4*)(kd + 64) = (u32x4){kst1[0], kst1[1], kst1[2], kst1[3]}; *(u32x4*)(kd + 72) = (u32x4){kst1[4], kst1[5], kst1[6], kst1[7]};
            if (rq == 0) *(f32x2_t*)(DCB + u * 256 + 2 * dp) = (f32x2_t){__expf(bl0), __expf(bl1)};
        }
        __syncthreads();
        u32x4 vreg[8];
#pragma unroll
        for (int i = 0; i < 8; ++i) { const int ch = tid + 512 * i, dv = ch >> 3, part = ch & 7; vreg[i] = *(const u32x4*)(VTA + ((size_t)((b * 4 + h) * 512 + dv)) * LTOT + c * 64 + part * 8); }
#pragma unroll
        for (int bi = 0; bi < 2; ++bi) {
            const int blk = wave * 2 + bi, tb = blk >> 2, sb = blk & 3;
            f32x4 lo = {0.f, 0.f, 0.f, 0.f}, up = {0.f, 0.f, 0.f, 0.f};
            if (tb >= sb) {
#pragma unroll
                for (int ks = 0; ks < 8; ++ks) {
                    const bf16x8 af = *(const LAS bf16x8*)(QLO + (tb * 16 + fr) * OPS + ks * 32 + fq * 8), bf = *(const LAS bf16x8*)(KLO + (sb * 16 + fr) * OPS + ks * 32 + fq * 8);
                    lo = __builtin_amdgcn_mfma_f32_16x16x32_bf16(af, bf, lo, 0, 0, 0);
                }
            }
            if (tb <= sb) {
#pragma unroll
                for (int ks = 0; ks < 8; ++ks) {
                    const bf16x8 af = *(const LAS bf16x8*)(QUP + (tb * 16 + fr) * OPS + ks * 32 + fq * 8), bf = *(const LAS bf16x8*)(KUP + (sb * 16 + fr) * OPS + ks * 32 + fq * 8);
                    up = __builtin_amdgcn_mfma_f32_16x16x32_bf16(af, bf, up, 0, 0, 0);
                }
            }
#pragma unroll
            for (int i = 0; i < 4; ++i) {
                const int t = tb * 16 + fq * 4 + i, s = sb * 16 + fr;
                const float val = (t >= s) ? lo[i] : up[i];
                PS[t * 72 + s] = (bf16_t)(cvt_pk_bf16_v(val, 0.f) & 0xffffu);
            }
        }
        __syncthreads();
#pragma unroll
        for (int i = 0; i < 8; ++i) { const int ch = tid + 512 * i, dv = ch >> 3, part = ch & 7; *(LAS u32x4*)(VT + dv * 72 + part * 8) = vreg[i]; }
        __syncthreads();
#pragma unroll
        for (int tb = 0; tb < 4; ++tb) {
            const bf16x8 a0 = *(const LAS bf16x8*)(PS + (tb * 16 + fr) * 72 + fq * 8), a1 = *(const LAS bf16x8*)(PS + (tb * 16 + fr) * 72 + 32 + fq * 8);
#pragma unroll
            for (int j = 0; j < 4; ++j) {
                const int dvb = wave * 4 + j;
                const bf16x8 b0 = *(const LAS bf16x8*)(VT + (dvb * 16 + fr) * 72 + fq * 8), b1 = *(const LAS bf16x8*)(VT + (dvb * 16 + fr) * 72 + 32 + fq * 8);
                f32x4 o = {0.f, 0.f, 0.f, 0.f};
                o = __builtin_amdgcn_mfma_f32_16x16x32_bf16(a0, b0, o, 0, 0, 0);
                o = __builtin_amdgcn_mfma_f32_16x16x32_bf16(a1, b1, o, 0, 0, 0);
#pragma unroll
                for (int i = 0; i < 4; ++i) HO[(size_t)(r0 + tb * 16 + fq * 4 + i) * DM + h * 512 + dvb * 16 + fr] = o[i];
            }
        }
        __syncthreads();
    }
}

__device__ __forceinline__ void gla_scan_phase(const Params& p, LAS unsigned char* lds) {
    constexpr int LEFT_CNT = 3520;
    unsigned* barw = (unsigned*)(p.ws + WS_BAR);
    if (blockIdx.x >= 128) {
        if (gridDim.x == 256) {
            if (blockIdx.x < 144) {
                gla_intra_phase(p, lds, 512 + (int)blockIdx.x - 128, 528, 1 << 20);
                asm volatile("s_waitcnt vmcnt(0)" ::: "memory");
                __syncthreads();
                if (threadIdx.x == 0) { __builtin_amdgcn_fence(__ATOMIC_RELEASE, "agent"); asm volatile("s_waitcnt vmcnt(0)" ::: "memory"); (void)xb_add(&barw[LEFT_CNT], 1u); }
            }
            tr_deferred(p, lds, (int)blockIdx.x - 128, 128, 2);
        }
        return;
    }
    const int tid = opaque_tid(), lane = tid & 63, wave = __builtin_amdgcn_readfirstlane(tid >> 6), fr = lane & 15, fq = lane >> 4;
    const int id = blockIdx.x, bh = id & 7, sl = id >> 3, b = bh >> 2, h = bh & 3, dv0 = sl * 32;
    const bf16_t* QA = (const bf16_t*)(p.ws + WS_QA); const bf16_t* VTA = (const bf16_t*)(p.ws + WS_VTA); const bf16_t* KST = (const bf16_t*)(p.ws + WS_KST);
    bf16_t* OI = (bf16_t*)(p.ws + WS_XN); const float* DCB = (const float*)(p.ws + WS_DC);
    LAS bf16_t* QI_s0 = (LAS bf16_t*)lds;
    LAS bf16_t* VT_s0 = (LAS bf16_t*)(lds + 67584);
    LAS float* DC_s0 = (LAS float*)(lds + 76800);
    LAS bf16_t* ST_s = (LAS bf16_t*)(lds + 78848);
    for (int e = tid; e < 32 * 264 / 2; e += 512) ((LAS unsigned*)ST_s)[e] = 0u;
    f32x4 S[2][2];
#pragma unroll
    for (int i = 0; i < 2; ++i)
#pragma unroll
        for (int j = 0; j < 2; ++j) S[i][j] = (f32x4){0.f, 0.f, 0.f, 0.f};
    const int tb = wave & 3, vb = wave >> 2;
    const bf16_t* kbase = KST + (size_t)(b * 264 + h) * 16384 + (size_t)(wave * 32 + fr) * 64 + fq * 8;
    u32x4 rqA[4], rvA = {0u, 0u, 0u, 0u}; bf16x8 kfA[2][2]; f32x4 rdcA = {0.f, 0.f, 0.f, 0.f}; float hoA[4];
    u32x4 rqB[4], rvB = {0u, 0u, 0u, 0u}; bf16x8 kfB[2][2]; f32x4 rdcB = {0.f, 0.f, 0.f, 0.f}; float hoB[4];
#define GLA_ISSUE(rq, kf, rv, rdc, ho, cstep) do { const int _c = (cstep); const int _r0 = b * LTOT + _c * 64; const int _u = b * 264 + _c * 4 + h; \
        _Pragma("unroll") for (int i = 0; i < 4; ++i) { const int ch = tid + 512 * i; rq[i] = *(const u32x4*)(QA + (size_t)(_r0 + (ch >> 5)) * GKD + h * 256 + (ch & 31) * 8); } \
        _Pragma("unroll") for (int di = 0; di < 2; ++di) { _Pragma("unroll") for (int ks = 0; ks < 2; ++ks) kf[di][ks] = *(const bf16x8*)(kbase + (size_t)_c * 65536 + di * 1024 + ks * 32); } \
        rv = *(const u32x4*)(VTA + ((size_t)((b * 4 + h) * 512 + dv0 + ((tid & 255) >> 3))) * LTOT + _c * 64 + (tid & 7) * 8); \
        rdc = ((const f32x4*)(DCB + _u * 256))[tid & 63]; \
        (void)ho; } while (0)
#define GLA_STEP(rq, kf, rv, rdc, ho, cstep) do { const int c = (cstep); const int cur = c & 1; \
        if (c == 60 && b == 1 && gridDim.x == 256) {     \
            if (threadIdx.x == 0) { XB_SPIN(xb_ld(&barw[LEFT_CNT]) < 16u, barw); __builtin_amdgcn_fence(__ATOMIC_ACQUIRE, "agent"); asm volatile("s_waitcnt vmcnt(0)" ::: "memory"); } \
            __syncthreads(); } \
        LAS bf16_t* QI_s = QI_s0 + cur * (64 * 264); LAS bf16_t* VT_s = VT_s0 + cur * (32 * 72); LAS float* DC_s = DC_s0 + cur * 256; \
        _Pragma("unroll") for (int i = 0; i < 4; ++i) { const int ch = tid + 512 * i; *(LAS u32x4*)(QI_s + (ch >> 5) * 264 + (ch & 31) * 8) = rq[i]; } \
        if (tid < 256) *(LAS u32x4*)(VT_s + (tid >> 3) * 72 + (tid & 7) * 8) = rv; \
        if (tid < 64) *(LAS f32x4*)(DC_s + tid * 4) = rdc; \
        const bf16x8 k00 = kf[0][0], k01 = kf[0][1], k10 = kf[1][0], k11 = kf[1][1]; \
        const int r0 = b * LTOT + c * 64; \
        GLA_ISSUE(rq, kf, rv, rdc, ho, (c + 2 < 66 ? c + 2 : 65));     \
        __syncthreads(); \
        { f32x4 o = {0.f, 0.f, 0.f, 0.f}; \
          LAS const bf16_t* st = ST_s + cur * (32 * 264); \
          _Pragma("unroll") for (int ks = 0; ks < 8; ++ks) { \
              const bf16x8 af = *(const LAS bf16x8*)(QI_s + (tb * 16 + fr) * 264 + ks * 32 + fq * 8), bf = *(const LAS bf16x8*)(st + (vb * 16 + fr) * 264 + ks * 32 + fq * 8); \
              o = __builtin_amdgcn_mfma_f32_16x16x32_bf16(af, bf, o, 0, 0, 0); } \
            \
          _Pragma("unroll") for (int i = 0; i < 4; ++i) OI[(size_t)(r0 + tb * 16 + fq * 4 + i) * DM + h * 512 + dv0 + vb * 16 + fr] = (bf16_t)(cvt_pk_bf16_v(o[i], 0.f) & 0xffffu); } \
        { LAS bf16_t* stn = ST_s + (cur ^ 1) * (32 * 264); \
          _Pragma("unroll") for (int di = 0; di < 2; ++di) { \
              const int db = wave * 2 + di; \
              const f32x4 dc = *(const LAS f32x4*)(DC_s + db * 16 + fq * 4); \
              const bf16x8 a0 = di ? k10 : k00, a1 = di ? k11 : k01; \
              _Pragma("unroll") for (int vj = 0; vj < 2; ++vj) { \
                  const bf16x8 b0 = *(const LAS bf16x8*)(VT_s + (vj * 16 + fr) * 72 + fq * 8), b1 = *(const LAS bf16x8*)(VT_s + (vj * 16 + fr) * 72 + 32 + fq * 8); \
                  f32x4 sv = S[di][vj] * dc; \
                  sv = __builtin_amdgcn_mfma_f32_16x16x32_bf16(a0, b0, sv, 0, 0, 0); \
                  sv = __builtin_amdgcn_mfma_f32_16x16x32_bf16(a1, b1, sv, 0, 0, 0); \
                  S[di][vj] = sv; \
                  const u32x2 wv = {cvt_pk_bf16_v(sv[0], sv[1]), cvt_pk_bf16_v(sv[2], sv[3])}; \
                  *(LAS u32x2*)(stn + (vj * 16 + fr) * 264 + db * 16 + fq * 4) = wv; } } } \
        } while (0)
    GLA_ISSUE(rqA, kfA, rvA, rdcA, hoA, 0);
    GLA_ISSUE(rqB, kfB, rvB, rdcB, hoB, 1);
#pragma unroll 11
    for (int cc = 0; cc < 66; cc += 2) {
        GLA_STEP(rqA, kfA, rvA, rdcA, hoA, cc);
        GLA_STEP(rqB, kfB, rvB, rdcB, hoB, cc + 1);
    }
    __syncthreads();
#undef GLA_STEP
#undef GLA_ISSUE
}

__device__ __forceinline__ void gla_out_phase(const Params& p) {
    const int tid = opaque_tid(), lane = tid & 63, wave = tid >> 6;
    const float* HO = (const float*)(p.ws + WS_HO); const bf16_t* GA = (const bf16_t*)(p.ws + WS_GA); bf16_t* OG = (bf16_t*)(p.ws + WS_OG);
    const bf16_t* OI = (const bf16_t*)(p.ws + WS_XN);
    const int gw = blockIdx.x * 8 + wave, ngw = gridDim.x * 8;
    for (int it = gw; it < MTOT * 4; it += ngw) {
        const int r = it >> 2, h = it & 3;
        const size_t base = (size_t)r * DM + h * 512 + lane * 8;
        f32x4 o0 = *(const f32x4*)(HO + base), o1 = *(const f32x4*)(HO + base + 4);
        { const u32x4 oi = *(const u32x4*)(OI + base); o0[0] += bf_lo(oi[0]); o0[1] += bf_hi(oi[0]); o0[2] += bf_lo(oi[1]); o0[3] += bf_hi(oi[1]); o1[0] += bf_lo(oi[2]); o1[1] += bf_hi(oi[2]); o1[2] += bf_lo(oi[3]); o1[3] += bf_hi(oi[3]); }
        float ss = (o0[0] * o0[0] + o0[1] * o0[1]) + (o0[2] * o0[2] + o0[3] * o0[3]) + (o1[0] * o1[0] + o1[1] * o1[1]) + (o1[2] * o1[2] + o1[3] * o1[3]);
        const float rstd = rsqrtf(wave_sum(ss) * (1.f / 512.f) + EPS);
        const f32x4 g0 = *(const f32x4*)(p.g_onorm_a + lane * 8), g1 = *(const f32x4*)(p.g_onorm_a + lane * 8 + 4);
        const u32x4 gw4 = *(const u32x4*)(GA + base);
        u32x4 w = {cvt_pk_bf16_v(o0[0] * rstd * g0[0] * bf_lo(gw4[0]), o0[1] * rstd * g0[1] * bf_hi(gw4[0])), cvt_pk_bf16_v(o0[2] * rstd * g0[2] * bf_lo(gw4[1]), o0[3] * rstd * g0[3] * bf_hi(gw4[1])),
                   cvt_pk_bf16_v(o1[0] * rstd * g1[0] * bf_lo(gw4[2]), o1[1] * rstd * g1[1] * bf_hi(gw4[2])), cvt_pk_bf16_v(o1[2] * rstd * g1[2] * bf_lo(gw4[3]), o1[3] * rstd * g1[3] * bf_hi(gw4[3]))};
        *(u32x4*)(OG + base) = w;
    }
}

__device__ __forceinline__ void attn_phase(const Params& p, LAS unsigned char* lds) {
    const int tid = opaque_tid(), lane = tid & 63, wave = __builtin_amdgcn_readfirstlane(tid >> 6), r = lane & 31, hh = lane >> 5;
    const bf16_t* QR = (const bf16_t*)(p.ws + WS_QR); const bf16_t* KN = (const bf16_t*)(p.ws + WS_KR); const bf16_t* VTB = (const bf16_t*)(p.ws + WS_VTB);
    bf16_t* OB = (bf16_t*)(p.ws + WS_OB);
    LAS bf16_t* K_s = (LAS bf16_t*)lds;
    LAS bf16_t* V_s = (LAS bf16_t*)(lds + 17408);
    LAS int* FLG = (LAS int*)(lds + 17408 + 18432);
    float gk[8];
    { const f32x4 ga = *(const f32x4*)(p.g_k + (tid & 15) * 8), gb = *(const f32x4*)(p.g_k + (tid & 15) * 8 + 4);
      gk[0] = ga[0]; gk[1] = ga[1]; gk[2] = ga[2]; gk[3] = ga[3]; gk[4] = gb[0]; gk[5] = gb[1]; gk[6] = gb[2]; gk[7] = gb[3]; }
    bf16x8 Tf[2];
#pragma unroll
    for (int s = 0; s < 2; ++s)
#pragma unroll
        for (int j = 0; j < 8; ++j) { const int key = 16 * s + 8 * (j >> 2) + 4 * hh + (j & 3); Tf[s][j] = (key >= r) ? (short)0x3F80 : (short)0; }
    for (int it = blockIdx.x; it < 544; it += gridDim.x) {
        int qb; if (it < 256) qb = 16 - (it >> 5); else if (it < 512) qb = 1 + ((it - 256) >> 5); else qb = 0;
        const int bhh = it & 31, b = bhh >> 4, h = bhh & 15;
        const int q0 = -128 + 256 * qb;
        const int qpos = q0 + 32 * wave + r;
        const int qmax_w = q0 + 32 * wave + 31;
        const bool wact = qmax_w >= PADN;
        bf16x8 qf[8];
        if (wact) {
            u32x4 raw[8]; float ss = 0.f;
#pragma unroll
            for (int ks = 0; ks < 8; ++ks) {
                raw[ks] = *(const u32x4*)(QR + (size_t)(b * LTOT + qpos) * DM + h * 128 + 16 * ks + 8 * hh);
#pragma unroll
                for (int e = 0; e < 4; ++e) { const float lo = bf_lo(raw[ks][e]), hi = bf_hi(raw[ks][e]); ss += lo * lo + hi * hi; }
            }
            ss += __shfl_xor(ss, 32);
            const float sc = rsqrtf(ss * (1.f / 128.f) + EPS) * 0.08838834764831845f;
#pragma unroll
            for (int ks = 0; ks < 8; ++ks) {
                const f32x4 ga = *(const f32x4*)(p.g_q_b + 16 * ks + 8 * hh), gb = *(const f32x4*)(p.g_q_b + 16 * ks + 8 * hh + 4);
                u32x4 w = {cvt_pk_bf16_v(bf_lo(raw[ks][0]) * sc * ga[0], bf_hi(raw[ks][0]) * sc * ga[1]), cvt_pk_bf16_v(bf_lo(raw[ks][1]) * sc * ga[2], bf_hi(raw[ks][1]) * sc * ga[3]),
                           cvt_pk_bf16_v(bf_lo(raw[ks][2]) * sc * gb[0], bf_hi(raw[ks][2]) * sc * gb[1]), cvt_pk_bf16_v(bf_lo(raw[ks][3]) * sc * gb[2], bf_hi(raw[ks][3]) * sc * gb[3])};
                qf[ks] = __builtin_bit_cast(bf16x8, w);
            }
        } else {
#pragma unroll
            for (int ks = 0; ks < 8; ++ks) qf[ks] = (bf16x8){0, 0, 0, 0, 0, 0, 0, 0};
        }
        f32x16 O[4];
#pragma unroll
        for (int d = 0; d < 4; ++d)
#pragma unroll
            for (int i = 0; i < 16; ++i) O[d][i] = 0.f;
        float carry = 0.f;
        bool wdone = !wact;
        const int kt_hi = (q0 + 254) >> 6;
        u32x4 rkk[2], rvv[2];
#define ATT_ISSUE(ktile) do { const int _k0 = (ktile) * 64; \
        _Pragma("unroll") for (int i = 0; i < 2; ++i) { const int ch = tid + 512 * i; \
            rkk[i] = *(const u32x4*)(KN + (size_t)(b * LTOT + _k0 + (ch >> 4)) * DM + h * 128 + (ch & 15) * 8); \
            rvv[i] = *(const u32x4*)(VTB + ((size_t)((b * 16 + h) * 128 + (ch >> 3))) * LTOT + _k0 + (ch & 7) * 8); } } while (0)
        ATT_ISSUE(kt_hi);
        for (int kt = kt_hi; kt >= 1; --kt) {
#pragma unroll
            for (int i = 0; i < 2; ++i) { const int ch = tid + 512 * i;
                const u32x4 w = rkk[i];
                float f[8] = {bf_lo(w[0]), bf_hi(w[0]), bf_lo(w[1]), bf_hi(w[1]), bf_lo(w[2]), bf_hi(w[2]), bf_lo(w[3]), bf_hi(w[3])};
                float ss = 0.f;
#pragma unroll
                for (int e = 0; e < 8; ++e) ss += f[e] * f[e];
                ss += __shfl_xor(ss, 1); ss += __shfl_xor(ss, 2); ss += __shfl_xor(ss, 4); ss += __shfl_xor(ss, 8);
                const float rs = rsqrtf(ss * (1.f / 128.f) + EPS);
                const u32x4 o = {cvt_pk_bf16_v(f[0] * rs * gk[0], f[1] * rs * gk[1]), cvt_pk_bf16_v(f[2] * rs * gk[2], f[3] * rs * gk[3]),
                                 cvt_pk_bf16_v(f[4] * rs * gk[4], f[5] * rs * gk[5]), cvt_pk_bf16_v(f[6] * rs * gk[6], f[7] * rs * gk[7])};
                *(LAS u32x4*)(K_s + (ch >> 4) * 136 + (ch & 15) * 8) = o; *(LAS u32x4*)(V_s + (ch >> 3) * 72 + (ch & 7) * 8) = rvv[i]; }
            if (kt > 1) ATT_ISSUE(kt - 1);
            __syncthreads();
            if (!wdone) {
#pragma unroll
                for (int sub = 1; sub >= 0; --sub) {
                    const int kb0 = kt * 64 + sub * 32;
                    if (kb0 <= qmax_w - 1 && kb0 + 31 >= PADN) {
                        f32x16 Z;
#pragma unroll
                        for (int i = 0; i < 16; ++i) Z[i] = 0.f;
#pragma unroll
                        for (int ks = 0; ks < 8; ++ks) {
                            const bf16x8 kf = *(const LAS bf16x8*)(K_s + (sub * 32 + r) * 136 + 16 * ks + 8 * hh);
                            Z = __builtin_amdgcn_mfma_f32_32x32x16_bf16(kf, qf[ks], Z, 0, 0, 0);
                        }
                        float lf[16]; float tot = 0.f; unsigned vmask = 0xffffu;
                        const bool interior = (kb0 + 31 < q0 + 32 * wave) && (kb0 >= PADN);
                        if (interior) {
#pragma unroll
                            for (int i = 0; i < 16; ++i) { lf[i] = log_sigmoid_f(-Z[i]); tot += lf[i]; }
                        } else {
                            vmask = 0u;
#pragma unroll
                            for (int i = 0; i < 16; ++i) {
                                const int key = kb0 + (i & 3) + 8 * (i >> 2) + 4 * hh;
                                const bool valid = (key < qpos) && (key >= PADN);
                                vmask |= valid ? (1u << i) : 0u;
                                lf[i] = valid ? log_sigmoid_f(-Z[i]) : 0.f;
                                tot += lf[i];
                            }
                        }
                        tot += __shfl_xor(tot, 32);
                        f32x16 Y;
#pragma unroll
                        for (int i = 0; i < 16; ++i) Y[i] = 0.f;
#pragma unroll
                        for (int s = 0; s < 2; ++s) {
                            unsigned hi4[4], lo4[4];
#pragma unroll
                            for (int e = 0; e < 4; ++e) {
                                const float x0 = lf[8 * s + 2 * e], x1 = lf[8 * s + 2 * e + 1];
                                const unsigned hw = cvt_pk_bf16_v(x0, x1);
                                hi4[e] = hw; lo4[e] = cvt_pk_bf16_v(x0 - bf_lo(hw), x1 - bf_hi(hw));
                            }
                            const u32x4 hv = {hi4[0], hi4[1], hi4[2], hi4[3]}, lv = {lo4[0], lo4[1], lo4[2], lo4[3]};
                            Y = __builtin_amdgcn_mfma_f32_32x32x16_bf16(Tf[s], __builtin_bit_cast(bf16x8, hv), Y, 0, 0, 0);
                            Y = __builtin_amdgcn_mfma_f32_32x32x16_bf16(Tf[s], __builtin_bit_cast(bf16x8, lv), Y, 0, 0, 0);
                        }
                        float att[16];
#pragma unroll
                        for (int i = 0; i < 16; ++i) att[i] = __expf(Z[i] + Y[i] + carry);
                        if (!interior) {
#pragma unroll
                            for (int i = 0; i < 16; ++i) att[i] = ((vmask >> i) & 1u) ? att[i] : 0.f;
                        }
                        carry += tot;
                        bf16x8 pa[2];
#pragma unroll
                        for (int s = 0; s < 2; ++s) {
                            const u32x4 w = {cvt_pk_bf16_v(att[8 * s], att[8 * s + 1]), cvt_pk_bf16_v(att[8 * s + 2], att[8 * s + 3]), cvt_pk_bf16_v(att[8 * s + 4], att[8 * s + 5]), cvt_pk_bf16_v(att[8 * s + 6], att[8 * s + 7])};
                            pa[s] = __builtin_bit_cast(bf16x8, w);
                        }
#pragma unroll
                        for (int dvb = 0; dvb < 4; ++dvb)
#pragma unroll
                            for (int s = 0; s < 2; ++s) {
                                const u32x2 v0 = *(const LAS u32x2*)(V_s + (dvb * 32 + r) * 72 + sub * 32 + 16 * s + 4 * hh);
                                const u32x2 v1 = *(const LAS u32x2*)(V_s + (dvb * 32 + r) * 72 + sub * 32 + 16 * s + 8 + 4 * hh);
                                const u32x4 vv = {v0[0], v0[1], v1[0], v1[1]};
                                O[dvb] = __builtin_amdgcn_mfma_f32_32x32x16_bf16(__builtin_bit_cast(bf16x8, vv), pa[s], O[dvb], 0, 0, 0);
                            }
                    }
                }
                if (__all(carry < -105.f)) wdone = true;
            }
            if (lane == 0) FLG[wave] = wdone ? 0 : 1;
            __syncthreads();
            const int anyw = FLG[0] | FLG[1] | FLG[2] | FLG[3] | FLG[4] | FLG[5] | FLG[6] | FLG[7];
            if (!anyw) break;
        }
        __syncthreads();
#undef ATT_ISSUE
        if (wact && qpos >= PADN) {
            bf16_t* orow = OB + (size_t)(b * LTOT + qpos) * DM + h * 128;
#pragma unroll
            for (int dvb = 0; dvb < 4; ++dvb)
#pragma unroll
                for (int g = 0; g < 4; ++g) {
                    const u32x2 w = {cvt_pk_bf16_v(O[dvb][4 * g], O[dvb][4 * g + 1]), cvt_pk_bf16_v(O[dvb][4 * g + 2], O[dvb][4 * g + 3])};
                    *(u32x2*)(orow + dvb * 32 + 8 * g + 4 * hh) = w;
                }
        }
    }
}


#define GRID_SYNC() do { asm volatile("s_waitcnt vmcnt(0)" ::: "memory"); grid.sync(); __builtin_amdgcn_fence(__ATOMIC_ACQUIRE, "agent"); asm volatile("s_waitcnt vmcnt(0)" ::: "memory"); } while (0)
__global__ void __launch_bounds__(512, 2) yoco_fwd(Params p) {
    extern __shared__ __attribute__((aligned(16))) unsigned char lds_raw[];
    LAS unsigned char* lds = (LAS unsigned char*)lds_raw;
    cg::grid_group grid = cg::this_grid();
    unsigned char* ws = p.ws;
    bf16_t* XN = (bf16_t*)(ws + WS_XN);
    float* HO = (float*)(ws + WS_HO);
    const int G = gridDim.x, bid = blockIdx.x;
    volatile LAS unsigned* xst = (volatile LAS unsigned*)(lds + LDS_BYTES - 16);
    if (threadIdx.x < 4) xst[threadIdx.x] = 0u;
    __syncthreads();
    XcdBarrier xb; xb.bar = (unsigned*)(p.ws + WS_BAR); xb.x = 0; xb.st = xst;
    if (p.ph_hi - p.ph_lo > 1) xb = xcd_barrier_post((unsigned*)(p.ws + WS_BAR), xst);
    if (p.ph_lo < 0) grid.sync();

#ifndef MK_DUMP
#define MK_DUMP 0
#endif
#ifndef MK_STOP
#define MK_STOP 17
#endif
#ifndef PROF_A
#define PROF_A -1
#endif
#ifndef PROF_B
#define PROF_B -1
#endif
#ifndef PROF_AMP
#define PROF_AMP 8
#endif
    unsigned long long tA0 = 0, tA1 = 0, tB0 = 0, tB1 = 0;
#define PROF_BEGIN(k) do { if ((k) == PROF_A) tA0 = __builtin_amdgcn_s_memrealtime(); if ((k) == PROF_B) tB0 = __builtin_amdgcn_s_memrealtime(); } while (0)
#define PROF_END(k) do { if ((k) == PROF_A) tA1 = __builtin_amdgcn_s_memrealtime(); if ((k) == PROF_B) tB1 = __builtin_amdgcn_s_memrealtime(); } while (0)
#define IN(k) (p.ph_lo <= (k) && (k) < p.ph_hi)
#define BOTH(k) (IN(k) && IN((k) + 1))
    if (IN(0)) { PROF_BEGIN(0);
    tr_region(lds, p.w_in_a, NIN, 2048, 6144, p.g_norm_a, (bf16_t*)(ws + WS_WIN), 0, 0, blockIdx.x, gridDim.x);
    if (gridDim.x != 256) tr_deferred(p, lds, blockIdx.x, gridDim.x, 7);
    norm_phase<true>(p, lds);
        if (BOTH(0)) xcd_barrier(xb);
        PROF_END(0);
    }
    if (IN(1)) { PROF_BEGIN(1);

    {
        pg8::Gemm g{XN, (const bf16_t*)(ws + WS_WIN), MTOT, 6144, 2048}; pg8::StaticOrder S; S.init(MTOT, 6144, 2048, G, bid);
        EpiIn E{(bf16_t*)(ws + WS_QA), (bf16_t*)(ws + WS_KA), (bf16_t*)(ws + WS_VTA), (bf16_t*)(ws + WS_GA), p.ph_hi > 0 ? 1.0f : 0.0f};
        pg8::gemm_phase<EpiIn, pg8::StaticOrder, true, true>(lds, g, S, E);
        if (G == 256 && bid >= 24) tr_deferred(p, lds, bid - 24, 232, 1);
    }
        if (BOTH(1)) xcd_barrier(xb);
        PROF_END(1);
    }
    if (IN(2)) { PROF_BEGIN(2);
    if (G == 256) gla_intra_phase(p, lds, bid, 512, 256);
    else gla_intra_phase(p, lds, bid, 528, G);
        if (BOTH(2)) xcd_barrier(xb);
        PROF_END(2);
    }
    if (IN(3)) { PROF_BEGIN(3);
    gla_scan_phase(p, lds);
        if (BOTH(3)) xcd_barrier(xb);
        PROF_END(3);
    }
    if (IN(4)) { PROF_BEGIN(4);
    gla_out_phase(p);
        if (BOTH(4)) xcd_barrier(xb);
        PROF_END(4);
    }
    if (IN(5)) { PROF_BEGIN(5);
    {
        pg8::Gemm g{(const bf16_t*)(ws + WS_OG), (const bf16_t*)(ws + WS_WOUTA), MTOT, 2048, 2048}; pg8::TailOrder S; S.init(2048, 2048, G, bid, 8);
        EpiRes<true, false, true> E{p.x, p.meta, p.out, HO, XN, (float*)(ws + WS_SSQ), (float*)(ws + WS_SLAB)};
        pg8::gemm_phase<EpiRes<true, false, true>, pg8::TailOrder, true, true>(lds, g, S, E);
    }
        if (BOTH(5)) xcd_barrier(xb);
        PROF_END(5);
    }
    if (IN(6)) { PROF_BEGIN(6);
    tail_fix_phase<true, false>(p, 8);
        if (BOTH(6)) xcd_barrier(xb);
        PROF_END(6);
    }
    if (IN(7)) { PROF_BEGIN(7);
    {
        pg8::Gemm g{XN, (const bf16_t*)(ws + WS_WF0), MTOT, 2 * DFF, 2048}; pg8::StaticOrder S; S.init(MTOT, 2 * DFF, 2048, G, bid);
        EpiSwiglu E{(bf16_t*)(ws + WS_ACT), (const float*)(ws + WS_SSQ)};
        pg8::gemm_phase<EpiSwiglu, pg8::StaticOrder, true, true>(lds, g, S, E);
    }
        if (BOTH(7)) xcd_barrier(xb);
        PROF_END(7);
    }
    if (IN(8)) { PROF_BEGIN(8);
    {
        pg8::Gemm g{(const bf16_t*)(ws + WS_ACT), (const bf16_t*)(ws + WS_WD0), MTOT, 2048, DFF}; pg8::TailOrder S; S.init(2048, DFF, G, bid, 11);
        EpiRes<false, false, true> E{p.x, p.meta, p.out, HO, XN, (float*)(ws + WS_SSQ), (float*)(ws + WS_SLAB)};
        pg8::gemm_phase<EpiRes<false, false, true>, pg8::TailOrder, true, true>(lds, g, S, E);
    }
        if (BOTH(8)) xcd_barrier(xb);
        PROF_END(8);
    }
    if (IN(9)) { PROF_BEGIN(9);
    tail_fix_phase<false, false>(p, 11);
        if (BOTH(9)) xcd_barrier(xb);
        PROF_END(9);
    }
    if (IN(10)) { PROF_BEGIN(10);
    {
        pg8::Gemm g{XN, (const bf16_t*)(ws + WS_WKVQ), MTOT, 6144, 2048}; pg8::StaticOrder S; S.init(MTOT, 6144, 2048, G, bid);
        EpiKvq E{(bf16_t*)(ws + WS_KR), (bf16_t*)(ws + WS_VTB), (bf16_t*)(ws + WS_QR), (const float*)(ws + WS_SSQ)};
        pg8::gemm_phase<EpiKvq, pg8::StaticOrder, true, true>(lds, g, S, E);
        if (G == 256 && bid >= 24) tr_deferred(p, lds, bid - 24, 232, 4);
    }
        if (BOTH(10)) xcd_barrier(xb);
        PROF_END(10);
    }
    if (IN(11)) { PROF_BEGIN(11);
        PROF_END(11);
    }
    if (IN(12)) { PROF_BEGIN(12);
    attn_phase(p, lds);
        if (BOTH(12)) xcd_barrier(xb);
        PROF_END(12);
    }
    if (IN(13)) { PROF_BEGIN(13);
    {
        pg8::Gemm g{(const bf16_t*)(ws + WS_OB), (const bf16_t*)(ws + WS_WOB), MTOT, 2048, 2048}; pg8::TailOrder S; S.init(2048, 2048, G, bid, 8);
        EpiRes<false, false, true> E{p.x, p.meta, p.out, HO, XN, (float*)(ws + WS_SSQ), (float*)(ws + WS_SLAB)};
        pg8::gemm_phase<EpiRes<false, false, true>, pg8::TailOrder, true, true>(lds, g, S, E);
    }
        if (BOTH(13)) xcd_barrier(xb);
        PROF_END(13);
    }
    if (IN(14)) { PROF_BEGIN(14);
    tail_fix_phase<false, false>(p, 8);
        if (BOTH(14)) xcd_barrier(xb);
        PROF_END(14);
    }
    if (IN(15)) { PROF_BEGIN(15);
    {
        pg8::Gemm g{XN, (const bf16_t*)(ws + WS_WF1), MTOT, 2 * DFF, 2048}; pg8::StaticOrder S; S.init(MTOT, 2 * DFF, 2048, G, bid);
        EpiSwiglu E{(bf16_t*)(ws + WS_ACT), (const float*)(ws + WS_SSQ)};
        pg8::gemm_phase<EpiSwiglu, pg8::StaticOrder, true, true>(lds, g, S, E);
    }
        if (BOTH(15)) xcd_barrier(xb);
        PROF_END(15);
    }
    if (IN(16)) { PROF_BEGIN(16);
    {
        pg8::Gemm g{(const bf16_t*)(ws + WS_ACT), (const bf16_t*)(ws + WS_WD1), MTOT, 2048, DFF}; pg8::TailOrder S; S.init(2048, DFF, G, bid, 11);
        EpiRes<false, true, false> E{p.x, p.meta, p.out, HO, XN, (float*)(ws + WS_SSQ), (float*)(ws + WS_SLAB)};
        pg8::gemm_phase<EpiRes<false, true, false>, pg8::TailOrder, true, true>(lds, g, S, E);
    }
        if (BOTH(16)) xcd_barrier(xb);
        PROF_END(16);
    }
    if (IN(17)) { PROF_BEGIN(17);
    tail_fix_phase<false, true>(p, 11);
    }
    if ((PROF_A != -1 || PROF_B != -1) && p.ph_hi == 18) {
        xcd_barrier(xb);
        if (PROF_A == 17) tA1 = __builtin_amdgcn_s_memrealtime();
        if (PROF_B == 17) tB1 = __builtin_amdgcn_s_memrealtime();
        if (blockIdx.x == 0) {
            const int n = PROF_A == 100 ? 1000 : (PROF_A >= 0 ? (int)((tA1 - tA0) / 100ull) : 0);
            for (int i = opaque_tid(); i < n; i += 512) p.out[(size_t)i * 163 + 7] += 0.2f;
            if (PROF_B >= 0) { const unsigned long long until = __builtin_amdgcn_s_memrealtime() + (tB1 - tB0) * (unsigned long long)PROF_AMP; while (__builtin_amdgcn_s_memrealtime() < until) __builtin_amdgcn_s_sleep(8); }
        }
    }
    if (IN(18)) {
        const int gt = blockIdx.x * 512 + opaque_tid(), ngt = gridDim.x * 512;
        for (size_t i = gt; i < (size_t)BATCH * SEQ * DM; i += ngt) {
            const size_t row = i / DM, c = i - row * DM; const size_t b = row / SEQ, t = row - b * SEQ; const size_t src = (b * LTOT + OFFS + t) * DM + c;
            float v;
            if (MK_DUMP == 0) v = HO[src];
            else if (MK_DUMP == 1) v = bf_lo((unsigned)XN[src]);
            else v = bf_lo((unsigned)((const bf16_t*)(ws + WS_R + (size_t)(MK_DUMP - 2) * SZ_ROW1K))[i]);
            p.out[i] = v;
        }
    }
#undef IN
#undef BOTH
}

extern "C" void kernel_launch(void* const* d_in, const int* in_sizes, int n_in, void* d_out, int out_size, void* d_ws, size_t ws_size, hipStream_t stream) {
    static int grid = 0;
    if (grid == 0) {
        if (n_in != 19 || ws_size < WS_TOTAL) { fprintf(stderr, "kernel_launch: expected 19 inputs and >= %zu bytes of workspace; got %d, %zu\n", (size_t)WS_TOTAL, n_in, ws_size); grid = -1; return; }
        int dev = 0, cus = 0, per_cu = 0;
        hipGetDevice(&dev);
        hipDeviceGetAttribute(&cus, hipDeviceAttributeMultiprocessorCount, dev);
        if (hipFuncSetAttribute((const void*)yoco_fwd, hipFuncAttributeMaxDynamicSharedMemorySize, LDS_BYTES) != hipSuccess) { fprintf(stderr, "kernel_launch: hipFuncSetAttribute failed\n"); grid = -1; return; }
        if (hipOccupancyMaxActiveBlocksPerMultiprocessor(&per_cu, (const void*)yoco_fwd, 512, LDS_BYTES) != hipSuccess || per_cu < 1) { fprintf(stderr, "kernel_launch: occupancy query says %d\n", per_cu); per_cu = 1; }
        (void)hipGetLastError();
        grid = cus * 1;
    }
    if (grid < 0) return;
    if (hipMemsetAsync((char*)d_ws + WS_BAR, 0, 16384, stream) != hipSuccess) { fprintf(stderr, "kernel_launch: memset of the barrier words failed\n"); return; }
    Params p{};
    p.x = (const float*)d_in[0]; p.meta = (const float*)d_in[1]; p.g_norm_a = (const float*)d_in[2]; p.w_in_a = (const float*)d_in[3]; p.w_gate_up_a = (const float*)d_in[4];
    p.b_gate_a = (const float*)d_in[5]; p.g_onorm_a = (const float*)d_in[6]; p.w_out_a = (const float*)d_in[7]; p.g_kv_norm = (const float*)d_in[8]; p.w_kv = (const float*)d_in[9];
    p.g_k = (const float*)d_in[10]; p.g_norm_b = (const float*)d_in[11]; p.w_q_b = (const float*)d_in[12]; p.g_q_b = (const float*)d_in[13]; p.w_o_b = (const float*)d_in[14];
    p.g_ffn_norm = (const float*)d_in[15]; p.w_ffn_gate = (const float*)d_in[16]; p.w_ffn_up = (const float*)d_in[17]; p.w_ffn_down = (const float*)d_in[18];
    p.out = (float*)d_out; p.ws = (unsigned char*)d_ws;
#ifndef MK_SPLIT
#define MK_SPLIT 0
#endif
    constexpr int NPH = 18;
    if (MK_SPLIT) {
        for (int k0 = 0; k0 <= MK_STOP + (MK_STOP < 17 ? 1 : 0); ++k0) {
            const int k = k0 <= MK_STOP ? k0 : 18;
            p.ph_lo = k; p.ph_hi = k + 1;
            void* args[] = {&p};
            hipError_t e = hipLaunchCooperativeKernel((const void*)yoco_fwd, dim3(grid), dim3(512), args, LDS_BYTES, stream);
            if (e != hipSuccess) { fprintf(stderr, "kernel_launch: launch %d failed: %s (grid %d)\n", k, hipGetErrorString(e), grid); break; }
        }
    } else {
        p.ph_lo = 0; p.ph_hi = NPH;
        void* args[] = {&p};
        hipError_t e = hipLaunchCooperativeKernel((const void*)yoco_fwd, dim3(grid), dim3(512), args, LDS_BYTES, stream);
        if (e != hipSuccess) fprintf(stderr, "kernel_launch: cooperative launch failed: %s (grid %d)\n", hipGetErrorString(e), grid);
    }
}
```

```cpp
#include <hip/hip_runtime.h>
#include <hip/hip_cooperative_groups.h>
#include <cstdio>
#include <cstdint>
namespace cg = cooperative_groups;

#define LAS __attribute__((address_space(3)))
typedef unsigned short bf16_t;
typedef short bf16x8 __attribute__((ext_vector_type(8)));
typedef float f32x4 __attribute__((ext_vector_type(4)));
typedef float f32x16 __attribute__((ext_vector_type(16)));
typedef unsigned u32x4 __attribute__((ext_vector_type(4)));
typedef unsigned u32x2 __attribute__((ext_vector_type(2)));

constexpr int BATCH = 2, SEQ = 4096, LTOT = 4224, DM = 2048, MTOT = BATCH * LTOT;
constexpr int PADN = 112, OFFS = 128;
constexpr int DFF = 5632, NIN = 6160;
constexpr int GKD = 1024;
constexpr float EPS = 1e-6f;

constexpr size_t SZ_WIN = (size_t)6144 * 2048 * 2, SZ_SQ = (size_t)2048 * 2048 * 2, SZ_WF = (size_t)11264 * 2048 * 2, SZ_WD = (size_t)2048 * 5632 * 2;
constexpr size_t WS_WIN = 0, WS_WOUTA = WS_WIN + SZ_WIN, WS_WF0 = WS_WOUTA + SZ_SQ, WS_WD0 = WS_WF0 + SZ_WF;
constexpr size_t WS_WKVQ = WS_WD0 + SZ_WD, WS_WOB = WS_WKVQ + SZ_WIN, WS_WF1 = WS_WOB + SZ_SQ, WS_WD1 = WS_WF1 + SZ_WF;
constexpr size_t WS_XN = WS_WD1 + SZ_WD;
constexpr size_t SZ_ROW2K = (size_t)MTOT * 2048 * 2, SZ_ROW1K = (size_t)MTOT * 1024 * 2;
constexpr size_t WS_R = WS_XN + SZ_ROW2K;
constexpr size_t WS_QA = WS_R, WS_KA = WS_QA + SZ_ROW1K, WS_VTA = WS_KA + SZ_ROW1K, WS_GA = WS_VTA + SZ_ROW2K, WS_KST = WS_GA + SZ_ROW2K;
constexpr size_t WS_REND = WS_KST + SZ_ROW1K;
constexpr size_t WS_ACT = WS_R;
constexpr size_t WS_KR = WS_R, WS_QR = WS_KR + SZ_ROW2K, WS_VTB = WS_QR + SZ_ROW2K;
static_assert(WS_ACT + (size_t)MTOT * DFF * 2 <= WS_REND && WS_VTB + SZ_ROW2K <= WS_REND, "region");
constexpr size_t WS_HO = WS_REND;
constexpr size_t WS_AG = WS_HO + (size_t)MTOT * 2048 * 4;
constexpr size_t WS_DC = WS_AG + (size_t)MTOT * 16 * 4;
constexpr size_t WS_SSQ = WS_DC + (size_t)528 * 256 * 4;
constexpr size_t WS_SLAB = WS_SSQ + (size_t)MTOT * 32 * 4;
constexpr size_t WS_END = WS_SLAB + (size_t)11 * 256 * 2048 * 4;
constexpr size_t WS_BAR = WS_END;
constexpr size_t WS_TOTAL = WS_BAR + 16384;
constexpr size_t WS_OG = WS_QA;
constexpr size_t WS_OB = WS_WIN;
static_assert(WS_OB + SZ_ROW2K <= WS_WD0, "OB overlays layer-A weights only");

constexpr int LDS_BYTES = 155648;

typedef __bf16 bf16x2_t __attribute__((ext_vector_type(2)));
typedef float f32x2_t __attribute__((ext_vector_type(2)));
__device__ __forceinline__ unsigned cvt_pk_bf16_v(float lo, float hi) { const f32x2_t v = {lo, hi}; const bf16x2_t b = __builtin_convertvector(v, bf16x2_t); return __builtin_bit_cast(unsigned, b); }
__device__ __forceinline__ unsigned cvt_pk_bf16(float lo, float hi) { unsigned r; asm("v_cvt_pk_bf16_f32 %0, %1, %2" : "=v"(r) : "v"(lo), "v"(hi)); return r; }
__device__ __forceinline__ float bf_lo(unsigned u) { return __builtin_bit_cast(float, u << 16); }
__device__ __forceinline__ float bf_hi(unsigned u) { return __builtin_bit_cast(float, u & 0xffff0000u); }
__device__ __forceinline__ float wave_sum(float v) {
#pragma unroll
    for (int o = 1; o < 64; o <<= 1) v += __shfl_xor(v, o);
    return v;
}
__device__ __forceinline__ int opaque_tid() { int t = threadIdx.x; asm volatile("" : "+v"(t)); return t; }
__device__ __forceinline__ unsigned char* opaque_ptr(unsigned char* q) { asm volatile("" : "+s"(q)); return q; }
__device__ __forceinline__ float silu_f(float x) { return x * __builtin_amdgcn_rcpf(1.f + __expf(-x)); }
__device__ __forceinline__ float log_sigmoid_f(float x) { return fminf(x, 0.f) - 0.6931471805599453f * __builtin_amdgcn_logf(1.f + __expf(-fabsf(x))); }

#define XB_TMO      128
#define XB_XCNT(j)  (256  + 64 * (j))
#define XB_XSUB(j)  (1280 + 64 * (j))
#define XB_XGEN(j)  (2304 + 64 * (j))
#define XB_TOP      3328
#define XB_TOPGEN   3392
#define XCD_BAR_WORDS 3456
#define XB_SPIN_CAP (1u << 20)
__device__ __forceinline__ unsigned xb_ld(unsigned* p)              { return __hip_atomic_load(p, __ATOMIC_RELAXED, __HIP_MEMORY_SCOPE_AGENT); }
__device__ __forceinline__ unsigned xb_add(unsigned* p, unsigned v) { return __hip_atomic_fetch_add(p, v, __ATOMIC_RELAXED, __HIP_MEMORY_SCOPE_AGENT); }
__device__ __forceinline__ unsigned xb_xcc_id() { return (unsigned)__builtin_amdgcn_s_getreg((3 << 11) | 20) & 0xFu; }
#define XB_SPIN(cond, bar) do { unsigned _sp = 0; while (cond) { __builtin_amdgcn_s_sleep(1); \
    if ((++_sp & 255u) == 0u) { if (xb_ld(&(bar)[XB_TMO])) break; if (_sp > XB_SPIN_CAP) { atomicAdd(&(bar)[XB_TMO], 1u); break; } } } } while (0)
struct XcdBarrier { unsigned* bar; unsigned x; volatile LAS unsigned* st; };
__device__ __forceinline__ XcdBarrier xcd_barrier_post(unsigned* bar, volatile LAS unsigned* st) {
    XcdBarrier b; b.bar = bar; b.x = xb_xcc_id(); b.st = st;
    if (threadIdx.x == 0) (void)xb_add(&bar[XB_XCNT(b.x)], 1u);
    return b;
}
__device__ __forceinline__ void xcd_barrier_complete(unsigned* bar, unsigned x, unsigned& nloc, unsigned& nx) {
    const unsigned G = gridDim.x * gridDim.y * gridDim.z;
    unsigned sum, cnt, mine, sp = 0u;
    for (;;) {
        sum = 0u; cnt = 0u; mine = 0u;
#pragma unroll
        for (unsigned j = 0; j < 16; ++j) { const unsigned c = xb_ld(&bar[XB_XCNT(j)]); sum += c; cnt += (c > 0u) ? 1u : 0u; mine = (j == x) ? c : mine; }
        if (sum == G) break;
        __builtin_amdgcn_s_sleep(1);
        if ((++sp & 255u) == 0u) { if (xb_ld(&bar[XB_TMO])) break; if (sp > XB_SPIN_CAP) { atomicAdd(&bar[XB_TMO], 1u); break; } }
    }
    nloc = mine > 0u ? mine : 1u; nx = cnt > 0u ? cnt : 1u;
}
__device__ __forceinline__ void xcd_barrier(const XcdBarrier& b) {
    asm volatile("s_waitcnt vmcnt(0)" ::: "memory");
    __syncthreads();
    if (threadIdx.x == 0) {
        unsigned* bar = b.bar;
        __builtin_amdgcn_s_waitcnt(0);
        unsigned nloc = b.st[0], nx = b.st[1];
        if (nloc == 0u) { xcd_barrier_complete(bar, b.x, nloc, nx); b.st[0] = nloc; b.st[1] = nx; }
        const unsigned old = xb_add(&bar[XB_XSUB(b.x)], 1u);
        const unsigned gen = old / nloc;
        if (old + 1u == (gen + 1u) * nloc) {
            __builtin_amdgcn_fence(__ATOMIC_RELEASE, "agent");
            asm volatile("s_waitcnt vmcnt(0)" ::: "memory");
            const unsigned og = xb_add(&bar[XB_TOP], 1u);
            const unsigned tg = og / nx;
            if (og + 1u == (tg + 1u) * nx) xb_add(&bar[XB_TOPGEN], 1u);
            else XB_SPIN(xb_ld(&bar[XB_TOPGEN]) == tg, bar);
            __builtin_amdgcn_fence(__ATOMIC_ACQUIRE, "agent");
            xb_add(&bar[XB_XGEN(b.x)], 1u);
            asm volatile("s_waitcnt vmcnt(0)" ::: "memory");
        } else {
            XB_SPIN(xb_ld(&bar[XB_XGEN(b.x)]) == gen, bar);
            __builtin_amdgcn_fence(__ATOMIC_ACQUIRE, "agent");
            asm volatile("s_waitcnt vmcnt(0)" ::: "memory");
        }
    }
    __syncthreads();
}


namespace pg8 {
constexpr int BM = 256, BK = 64, HALF = 128, HTB = HALF * BK * 2, NXCD = 8, WGM = 8;
__host__ __device__ __forceinline__ int lds_byte(int r, int c) { const int st = (r >> 4) * 2 + (c >> 5), rr = r & 15, cc = c & 31, ob = rr * 64 + cc * 2; return st * 1024 + (ob ^ (((ob >> 9) & 1) << 5)); }
__host__ __device__ __forceinline__ void stage_rc(int b, int& R, int& C) { const int st = b / 1024, sb = b % 1024, swz = sb ^ (((sb >> 9) & 1) << 5); R = (st >> 1) * 16 + swz / 64; C = (st & 1) * 32 + (swz % 64) / 2; }
__host__ __device__ __forceinline__ int perm32(int rho) { const int n = rho >> 4, i = rho & 15; return 8 * (i >> 2) + 4 * n + (i & 3); }
struct Unit { int pm, pn, kb, nt, split; };
struct Gemm { const bf16_t* A; const bf16_t* Bt; int M, N, K; };
struct StaticOrder {
    int nM, nN, nwg, G, c, ntf;
    __host__ __device__ void init(int M, int N, int K, int G_, int c_) { nM = M / BM; nN = N / BM; nwg = nM * nN; G = G_; c = c_; ntf = K / BK; }
    __host__ __device__ void map(long L, Unit& u) const {
        int wgid = (int)L; { const int q = nwg / NXCD, r = nwg % NXCD, xcd = wgid % NXCD, off = wgid / NXCD; wgid = (xcd < r ? xcd * (q + 1) : r * (q + 1) + (xcd - r) * q) + off; }
        const int nig = WGM * nN, gid = wgid / nig, fm = gid * WGM, gsz = (nM - fm) < WGM ? (nM - fm) : WGM;
        u.pm = fm + ((wgid % nig) % gsz); u.pn = (wgid % nig) / gsz; u.kb = 0; u.nt = ntf; u.split = 0;
    }
    __host__ __device__ bool next(int i, Unit& u) const { const long L = (long)i * G + c; if (L >= nwg) return false; map(L, u); return true; }
    __device__ __forceinline__ void a_ready(const Unit&) const {}
    __device__ __forceinline__ void done(const Unit&) const {}
};
struct TailOrder {
    StaticOrder so; int ntu, nun;
    __host__ __device__ void init(int N, int K, int G_, int c_, int nsplit) { so.init(8192, N, K, G_, c_); ntu = (K / BK) / nsplit; nun = so.nN * nsplit; }
    __host__ __device__ bool next(int i, Unit& u) const {
        const long L = (long)i * so.G + so.c;
        if (L < so.nwg) { so.map(L, u); return true; }
        const long j = L - so.nwg; if (j >= nun) return false;
        u.pm = so.nM; u.pn = (int)(j % so.nN); const int sidx = (int)(j / so.nN); u.kb = sidx * ntu * (BK * 2); u.nt = ntu; u.split = 1 + sidx; return true;
    }
    __device__ __forceinline__ void a_ready(const Unit&) const {}
    __device__ __forceinline__ void done(const Unit&) const {}
};
template <class Epi, class Sched, bool ALIGN_EPI = false, bool SP2 = false>
__device__ __forceinline__ void gemm_phase(LAS unsigned char* lds, const Gemm g, const Sched& S, const Epi& E) {
    const int tid = opaque_tid(), wid = __builtin_amdgcn_readfirstlane(tid >> 6), lane = tid & 63, wr = wid >> 2, wc = wid & 3, fr = lane & 15, fq = lane >> 4;
    const int K = g.K;
    unsigned voffA[2], voffB[2];
#pragma unroll
    for (int i = 0; i < 2; ++i) { int R, C; stage_rc(tid * 16 + i * 8192, R, C); const int Rb = Epi::PERM ? ((R & ~31) + perm32(R & 31)) : R;
        voffA[i] = (unsigned)(R * K + C) * 2u; voffB[i] = (unsigned)(Rb * K + C) * 2u; }
    const size_t kstep = (size_t)(BK * 2);
    const size_t hstep = (size_t)HALF * K * 2;
    const size_t tstep = 2 * hstep;
    const unsigned ldsw = (unsigned)wid * 1024u;
    const int aoff = lds_byte(wr * 64 + fr, fq * 8), boff = lds_byte(wc * 32 + fr, fq * 8);
#define PG8_SA(b, h) (((b) * 2 + (h)) * HTB)
#define PG8_SB(b, h) ((4 + (b) * 2 + (h)) * HTB)
#define PG8_STAGE(bufoff, gbase, voff) do { _Pragma("unroll") for (int _i = 0; _i < 2; ++_i) \
        __builtin_amdgcn_global_load_lds((const unsigned*)((const char*)(gbase) + (voff)[_i]), (LAS unsigned*)(lds + (bufoff) + ldsw + _i * 8192), 16, 0, 0); } while (0)
#define PG8_LDA(dst, b, h) do { _Pragma("unroll") for (int m = 0; m < 4; ++m) _Pragma("unroll") for (int k = 0; k < 2; ++k) dst[m][k] = *(const LAS bf16x8*)(lds + PG8_SA(b, h) + aoff + m * 2048 + k * 1024); } while (0)
#define PG8_LDB(dst, b, h) do { _Pragma("unroll") for (int n = 0; n < 2; ++n) _Pragma("unroll") for (int k = 0; k < 2; ++k) dst[n][k] = *(const LAS bf16x8*)(lds + PG8_SB(b, h) + boff + n * 2048 + k * 1024); } while (0)
#define PG8_MMA(ai, bj, At, Bt) do { __builtin_amdgcn_s_setprio(1); _Pragma("unroll") for (int m = 0; m < 4; ++m) _Pragma("unroll") for (int n = 0; n < 2; ++n) _Pragma("unroll") for (int k = 0; k < 2; ++k) \
        acc[ai][bj][m][n] = __builtin_amdgcn_mfma_f32_16x16x32_bf16(Bt[n][k], At[m][k], acc[ai][bj][m][n], 0, 0, 0); __builtin_amdgcn_s_setprio(0); } while (0)
#define PG8_WAIT_V(n) asm volatile("s_waitcnt vmcnt(" #n ")" ::: "memory")
#define PG8_WAIT_L(n) asm volatile("s_waitcnt lgkmcnt(" #n ")" ::: "memory")
#define PG8_BAR __builtin_amdgcn_s_barrier()
#define PG8_SCHED __builtin_amdgcn_sched_barrier(0)
    Unit cur, nxt; int ui = 0;
    if (!S.next(0, cur)) return;
    f32x4 acc[2][2][4][2];
#pragma unroll
    for (int a = 0; a < 2; ++a)
#pragma unroll
        for (int b = 0; b < 2; ++b)
#pragma unroll
            for (int m = 0; m < 4; ++m)
#pragma unroll
                for (int n = 0; n < 2; ++n) acc[a][b][m][n] = (f32x4){0.f, 0.f, 0.f, 0.f};
    bf16x8 At[4][2], B0[2][2], B1[2][2];
    const char* cA = (const char*)g.A + (size_t)cur.pm * tstep + cur.kb; const char* cB = (const char*)g.Bt + (size_t)cur.pn * tstep + cur.kb;
    S.a_ready(cur);
    if constexpr (SP2) {
        PG8_STAGE(PG8_SB(0, 0), cB, voffB); PG8_STAGE(PG8_SB(0, 1), cB + hstep, voffB); PG8_STAGE(PG8_SA(0, 0), cA, voffA); PG8_STAGE(PG8_SA(0, 1), cA + hstep, voffA);
        if (wr == 1) PG8_BAR;
        PG8_WAIT_V(2); PG8_BAR;
        PG8_STAGE(PG8_SB(1, 0), cB + kstep, voffB); PG8_STAGE(PG8_SA(1, 0), cA + kstep, voffA); PG8_STAGE(PG8_SB(1, 1), cB + hstep + kstep, voffB);
        PG8_WAIT_V(6); PG8_BAR;
    } else {
        PG8_STAGE(PG8_SB(0, 0), cB, voffB); PG8_STAGE(PG8_SA(0, 0), cA, voffA); PG8_STAGE(PG8_SB(0, 1), cB + hstep, voffB); PG8_STAGE(PG8_SA(0, 1), cA + hstep, voffA);
        if (wr == 1) PG8_BAR;
        PG8_WAIT_V(4); PG8_BAR;
        PG8_STAGE(PG8_SB(1, 0), cB + kstep, voffB); PG8_STAGE(PG8_SA(1, 0), cA + kstep, voffA); PG8_STAGE(PG8_SB(1, 1), cB + hstep + kstep, voffB);
        PG8_WAIT_V(6); PG8_BAR;
    }
    for (;;) {
        const bool has_next = S.next(ui + 1, nxt);
        const char* nA = has_next ? (const char*)g.A + (size_t)nxt.pm * tstep + nxt.kb : cA; const char* nB = has_next ? (const char*)g.Bt + (size_t)nxt.pn * tstep + nxt.kb : cB;
        const int nt = cur.nt;
        for (int t = 0; t < nt; t += 2) {
            const bool last = (t == nt - 2);
            const char* a1 = cA + (size_t)(t + 1) * kstep;
            const char* a2 = last ? nA : cA + (size_t)(t + 2) * kstep; const char* b2 = last ? nB : cB + (size_t)(t + 2) * kstep;
            const char* a3 = a2 + kstep; const char* b3 = b2 + kstep;
            if (last && has_next) S.a_ready(nxt);
            if constexpr (SP2) {
            PG8_LDB(B0, 0, 0); PG8_LDB(B1, 0, 1); PG8_SCHED; PG8_LDA(At, 0, 0); PG8_STAGE(PG8_SA(1, 1), a1 + hstep, voffA);
            PG8_WAIT_V(8); PG8_WAIT_L(0); PG8_BAR; PG8_MMA(0, 0, At, B0); PG8_MMA(0, 1, At, B1); PG8_BAR; PG8_SCHED;
            PG8_LDA(At, 0, 1); PG8_STAGE(PG8_SB(0, 0), b2, voffB); PG8_STAGE(PG8_SB(0, 1), b2 + hstep, voffB); PG8_STAGE(PG8_SA(0, 0), a2, voffA);
            PG8_WAIT_V(8); PG8_WAIT_L(0); PG8_BAR; PG8_MMA(1, 0, At, B0); PG8_MMA(1, 1, At, B1); PG8_BAR; PG8_SCHED;
            PG8_LDB(B0, 1, 0); PG8_LDB(B1, 1, 1); PG8_SCHED; PG8_LDA(At, 1, 0); PG8_STAGE(PG8_SA(0, 1), a2 + hstep, voffA);
            PG8_WAIT_V(8); PG8_WAIT_L(0); PG8_BAR; PG8_MMA(0, 0, At, B0); PG8_MMA(0, 1, At, B1); PG8_BAR; PG8_SCHED;
            PG8_LDA(At, 1, 1); PG8_STAGE(PG8_SB(1, 0), b3, voffB); PG8_STAGE(PG8_SB(1, 1), b3 + hstep, voffB); PG8_STAGE(PG8_SA(1, 0), a3, voffA);
            PG8_WAIT_V(8); PG8_WAIT_L(0); PG8_BAR; PG8_MMA(1, 0, At, B0); PG8_MMA(1, 1, At, B1); PG8_BAR; PG8_SCHED;
            } else {
            PG8_LDB(B0, 0, 0); PG8_SCHED; PG8_LDA(At, 0, 0); PG8_STAGE(PG8_SA(1, 1), a1 + hstep, voffA);
            PG8_WAIT_L(8); PG8_BAR; PG8_WAIT_L(0); PG8_MMA(0, 0, At, B0); PG8_BAR; PG8_SCHED;
            PG8_LDB(B1, 0, 1); PG8_STAGE(PG8_SB(0, 0), b2, voffB);
            PG8_BAR; PG8_WAIT_L(0); PG8_MMA(0, 1, At, B1); PG8_BAR;
            PG8_LDA(At, 0, 1); PG8_STAGE(PG8_SA(0, 0), a2, voffA);
            PG8_BAR; PG8_WAIT_L(0); PG8_MMA(1, 0, At, B0); PG8_BAR; PG8_SCHED;
            PG8_STAGE(PG8_SB(0, 1), b2 + hstep, voffB);
            PG8_WAIT_V(6); PG8_BAR; PG8_MMA(1, 1, At, B1); PG8_BAR;
            PG8_LDB(B0, 1, 0); PG8_SCHED; PG8_LDA(At, 1, 0); PG8_STAGE(PG8_SA(0, 1), a2 + hstep, voffA);
            PG8_WAIT_L(8); PG8_BAR; PG8_WAIT_L(0); PG8_MMA(0, 0, At, B0); PG8_BAR; PG8_SCHED;
            PG8_LDB(B1, 1, 1); PG8_STAGE(PG8_SB(1, 0), b3, voffB);
            PG8_BAR; PG8_WAIT_L(0); PG8_MMA(0, 1, At, B1); PG8_BAR;
            PG8_LDA(At, 1, 1); PG8_STAGE(PG8_SA(1, 0), a3, voffA);
            PG8_BAR; PG8_WAIT_L(0); PG8_MMA(1, 0, At, B0); PG8_BAR; PG8_SCHED;
            PG8_STAGE(PG8_SB(1, 1), b3 + hstep, voffB);
            PG8_WAIT_V(6); PG8_BAR; PG8_MMA(1, 1, At, B1); PG8_BAR;
            }
        }
        if constexpr (ALIGN_EPI) { if (wr == 0) PG8_BAR; }
        if constexpr (!Epi::AFTER_DRAIN) { E(acc, cur, wr, wc, fr, fq); S.done(cur); }
        if (!has_next) break;
#pragma unroll
        for (int a = 0; a < 2; ++a)
#pragma unroll
            for (int b = 0; b < 2; ++b)
#pragma unroll
                for (int m = 0; m < 4; ++m)
#pragma unroll
                    for (int n = 0; n < 2; ++n) acc[a][b][m][n] = (f32x4){0.f, 0.f, 0.f, 0.f};
        cur = nxt; cA = nA; cB = nB; ++ui;
        if constexpr (ALIGN_EPI) { if (wr == 1) PG8_BAR; }
    }
    PG8_WAIT_V(0);
    if constexpr (!ALIGN_EPI) { if (wr == 0) PG8_BAR; }
    PG8_BAR;
#undef PG8_SA
#undef PG8_SB
#undef PG8_STAGE
#undef PG8_LDA
#undef PG8_LDB
#undef PG8_MMA
#undef PG8_WAIT_V
#undef PG8_WAIT_L
#undef PG8_BAR
#undef PG8_SCHED
}
}

struct Params {
    const float *x, *meta, *g_norm_a, *w_in_a, *w_gate_up_a, *b_gate_a, *g_onorm_a, *w_out_a, *g_kv_norm, *w_kv, *g_k, *g_norm_b, *w_q_b, *g_q_b, *w_o_b,
        *g_ffn_norm, *w_ffn_gate, *w_ffn_up, *w_ffn_down;
    float* out;
    unsigned char* ws;
    int ph_lo, ph_hi;
};

__device__ __forceinline__ const float* h0_row(const Params& p, int r) {
    const int b = r >= LTOT ? 1 : 0, pos = r - b * LTOT;
    if (pos < PADN) return nullptr;
    if (pos < OFFS) return p.meta + (size_t)(pos - PADN) * DM;
    return p.x + ((size_t)b * SEQ + (pos - OFFS)) * DM;
}

struct EpiIn {
    static constexpr bool PERM = true, AFTER_DRAIN = false;
    bf16_t *QA, *KA, *VTA, *GA; float one;
    __device__ __forceinline__ void operator()(const f32x4 (&acc)[2][2][4][2], const pg8::Unit& u, int wr, int wc, int fr, int fq) const {
        const int pn = u.pn;
#pragma unroll
        for (int ai = 0; ai < 2; ++ai)
#pragma unroll
            for (int m = 0; m < 4; ++m) {
                const int r = u.pm * 256 + ai * 128 + wr * 64 + m * 16 + fr;
#pragma unroll
                for (int bj = 0; bj < 2; ++bj) {
                    const int c = pn * 256 + bj * 128 + wc * 32 + fq * 8;
                    const f32x4 v0 = acc[ai][bj][m][0] * one, v1 = acc[ai][bj][m][1] * one;
                    if (pn < 4) {
                        const float sc = 0.0625f;
                        u32x4 w = {cvt_pk_bf16(v0[0] * sc, v0[1] * sc), cvt_pk_bf16(v0[2] * sc, v0[3] * sc), cvt_pk_bf16(v1[0] * sc, v1[1] * sc), cvt_pk_bf16(v1[2] * sc, v1[3] * sc)};
                        *(u32x4*)(QA + (size_t)r * GKD + c) = w;
                    } else if (pn < 8) {
                        u32x4 w = {cvt_pk_bf16(v0[0], v0[1]), cvt_pk_bf16(v0[2], v0[3]), cvt_pk_bf16(v1[0], v1[1]), cvt_pk_bf16(v1[2], v1[3])};
                        *(u32x4*)(KA + (size_t)r * GKD + (c - 1024)) = w;
                    } else if (pn < 16) {
                        const int cv = c - 2048, hh = cv >> 9, dv = cv & 511;
                        const int b = r >= LTOT ? 1 : 0, pos = r - b * LTOT;
                        bf16_t* dst = VTA + ((size_t)((b * 4 + hh) * 512 + dv)) * LTOT + pos;
                        const unsigned w0 = cvt_pk_bf16(v0[0], v0[1]), w1 = cvt_pk_bf16(v0[2], v0[3]), w2 = cvt_pk_bf16(v1[0], v1[1]), w3 = cvt_pk_bf16(v1[2], v1[3]);
                        dst[0] = (bf16_t)w0; dst[(size_t)LTOT] = (bf16_t)(w0 >> 16); dst[(size_t)2 * LTOT] = (bf16_t)w1; dst[(size_t)3 * LTOT] = (bf16_t)(w1 >> 16);
                        dst[(size_t)4 * LTOT] = (bf16_t)w2; dst[(size_t)5 * LTOT] = (bf16_t)(w2 >> 16); dst[(size_t)6 * LTOT] = (bf16_t)w3; dst[(size_t)7 * LTOT] = (bf16_t)(w3 >> 16);
                    } else {
                        u32x4 w = {cvt_pk_bf16(silu_f(v0[0]), silu_f(v0[1])), cvt_pk_bf16(silu_f(v0[2]), silu_f(v0[3])), cvt_pk_bf16(silu_f(v1[0]), silu_f(v1[1])), cvt_pk_bf16(silu_f(v1[2]), silu_f(v1[3]))};
                        *(u32x4*)(GA + (size_t)r * DM + (c - 4096)) = w;
                    }
                }
            }
    }
};
struct EpiKvq {
    static constexpr bool PERM = true, AFTER_DRAIN = false;
    bf16_t *KR, *VTB, *QR; const float* SSQ;
    __device__ __forceinline__ void operator()(const f32x4 (&acc)[2][2][4][2], const pg8::Unit& u, int wr, int wc, int fr, int fq) const {
        const int pn = u.pn;
#pragma unroll
        for (int ai = 0; ai < 2; ++ai)
#pragma unroll
            for (int m = 0; m < 4; ++m) {
                const int r = u.pm * 256 + ai * 128 + wr * 64 + m * 16 + fr;
                float rsv;
                { const f32x4 a = *(const f32x4*)(SSQ + (size_t)r * 32 + fq * 8), b = *(const f32x4*)(SSQ + (size_t)r * 32 + fq * 8 + 4);
                  float t = ((a[0] + a[1]) + (a[2] + a[3])) + ((b[0] + b[1]) + (b[2] + b[3]));
                  t += __shfl_xor(t, 16); t += __shfl_xor(t, 32);
                  rsv = rsqrtf(t * (1.f / DM) + EPS); }
#pragma unroll
                for (int bj = 0; bj < 2; ++bj) {
                    const int c = pn * 256 + bj * 128 + wc * 32 + fq * 8;
                    const f32x4 v0 = acc[ai][bj][m][0] * rsv, v1 = acc[ai][bj][m][1] * rsv;
                    const unsigned w0 = cvt_pk_bf16(v0[0], v0[1]), w1 = cvt_pk_bf16(v0[2], v0[3]), w2 = cvt_pk_bf16(v1[0], v1[1]), w3 = cvt_pk_bf16(v1[2], v1[3]);
                    if (pn < 8) {
                        u32x4 w = {w0, w1, w2, w3};
                        *(u32x4*)(KR + (size_t)r * DM + c) = w;
                    } else if (pn < 16) {
                        const int cv = c - 2048, hh = cv >> 7, dv = cv & 127;
                        const int b = r >= LTOT ? 1 : 0, pos = r - b * LTOT;
                        bf16_t* dst = VTB + ((size_t)((b * 16 + hh) * 128 + dv)) * LTOT + pos;
                        dst[0] = (bf16_t)w0; dst[(size_t)LTOT] = (bf16_t)(w0 >> 16); dst[(size_t)2 * LTOT] = (bf16_t)w1; dst[(size_t)3 * LTOT] = (bf16_t)(w1 >> 16);
                        dst[(size_t)4 * LTOT] = (bf16_t)w2; dst[(size_t)5 * LTOT] = (bf16_t)(w2 >> 16); dst[(size_t)6 * LTOT] = (bf16_t)w3; dst[(size_t)7 * LTOT] = (bf16_t)(w3 >> 16);
                    } else {
                        u32x4 w = {w0, w1, w2, w3};
                        *(u32x4*)(QR + (size_t)r * DM + (c - 4096)) = w;
                    }
                }
            }
    }
};
struct EpiSwiglu {
    static constexpr bool PERM = true, AFTER_DRAIN = false;
    bf16_t* ACT; const float* SSQ;
    __device__ __forceinline__ void operator()(const f32x4 (&acc)[2][2][4][2], const pg8::Unit& u, int wr, int wc, int fr, int fq) const {
#pragma unroll
        for (int ai = 0; ai < 2; ++ai)
#pragma unroll
            for (int m = 0; m < 4; ++m) {
                const int r = u.pm * 256 + ai * 128 + wr * 64 + m * 16 + fr;
                float rsv;
                { const f32x4 a = *(const f32x4*)(SSQ + (size_t)r * 32 + fq * 8), b = *(const f32x4*)(SSQ + (size_t)r * 32 + fq * 8 + 4);
                  float t = ((a[0] + a[1]) + (a[2] + a[3])) + ((b[0] + b[1]) + (b[2] + b[3]));
                  t += __shfl_xor(t, 16); t += __shfl_xor(t, 32);
                  rsv = rsqrtf(t * (1.f / DM) + EPS); }
                const int c = u.pn * 128 + wc * 32 + fq * 8;
                const f32x4 g0 = acc[ai][0][m][0] * rsv, g1 = acc[ai][0][m][1] * rsv, u0 = acc[ai][1][m][0] * rsv, u1 = acc[ai][1][m][1] * rsv;
                u32x4 w = {cvt_pk_bf16(silu_f(g0[0]) * u0[0], silu_f(g0[1]) * u0[1]), cvt_pk_bf16(silu_f(g0[2]) * u0[2], silu_f(g0[3]) * u0[3]),
                           cvt_pk_bf16(silu_f(g1[0]) * u1[0], silu_f(g1[1]) * u1[1]), cvt_pk_bf16(silu_f(g1[2]) * u1[2], silu_f(g1[3]) * u1[3])};
                *(u32x4*)(ACT + (size_t)r * DFF + c) = w;
            }
    }
};
template <bool SRC0, bool FINAL, bool WXN>
struct EpiRes {
    static constexpr bool PERM = true, AFTER_DRAIN = false;
    const float *x, *meta; float *out, *HO; bf16_t* XN; float *SSQ, *SLAB;
    __device__ __forceinline__ void operator()(const f32x4 (&acc)[2][2][4][2], const pg8::Unit& u, int wr, int wc, int fr, int fq) const {
        if (u.split) {
            char* slab = (char*)SLAB + (size_t)(u.split - 1) * 256 * DM * 4;
#pragma unroll
            for (int ai = 0; ai < 2; ++ai)
#pragma unroll
                for (int m = 0; m < 4; ++m) {
                    const int rl = ai * 128 + wr * 64 + m * 16 + fr;
#pragma unroll
                    for (int bj = 0; bj < 2; ++bj) {
                        const unsigned bo = ((unsigned)rl * DM + (unsigned)(u.pn * 256 + bj * 128 + wc * 32 + fq * 8)) * 4u;
                        *(f32x4*)(slab + bo) = acc[ai][bj][m][0]; *(f32x4*)(slab + bo + 16) = acc[ai][bj][m][1];
                    }
                }
            return;
        }
#pragma unroll
        for (int ai = 0; ai < 2; ++ai)
#pragma unroll
            for (int m = 0; m < 4; ++m) {
                const int r = u.pm * 256 + ai * 128 + wr * 64 + m * 16 + fr;
                const int b = r >= LTOT ? 1 : 0, pos = r - b * LTOT;
                const unsigned c0 = (unsigned)(u.pn * 256 + wc * 32 + fq * 8);
                const unsigned eh = (unsigned)r * DM + c0;
                const unsigned eo = ((unsigned)(b * SEQ + (pos - OFFS))) * DM + c0;
                float ss = 0.f;
#pragma unroll
                for (int bj = 0; bj < 2; ++bj) {
                    f32x4 r0 = {0.f, 0.f, 0.f, 0.f}, r1 = {0.f, 0.f, 0.f, 0.f};
                    if (SRC0) {
                        if (pos >= OFFS) { r0 = *(const f32x4*)((const char*)x + (eo + bj * 128) * 4u); r1 = *(const f32x4*)((const char*)x + (eo + bj * 128) * 4u + 16); }
                        else if (pos >= PADN) { const unsigned em = ((unsigned)(pos - PADN) * DM + c0 + bj * 128) * 4u; r0 = *(const f32x4*)((const char*)meta + em); r1 = *(const f32x4*)((const char*)meta + em + 16); }
                    } else { r0 = *(const f32x4*)((const char*)HO + (eh + bj * 128) * 4u); r1 = *(const f32x4*)((const char*)HO + (eh + bj * 128) * 4u + 16); }
                    r0 += acc[ai][bj][m][0]; r1 += acc[ai][bj][m][1];
                    if (FINAL) { if (pos >= OFFS) { *(f32x4*)((char*)out + (eo + bj * 128) * 4u) = r0; *(f32x4*)((char*)out + (eo + bj * 128) * 4u + 16) = r1; } }
                    else { *(f32x4*)((char*)HO + (eh + bj * 128) * 4u) = r0; *(f32x4*)((char*)HO + (eh + bj * 128) * 4u + 16) = r1; }
                    if (WXN) {
                        ss += ((r0[0] * r0[0] + r0[1] * r0[1]) + (r0[2] * r0[2] + r0[3] * r0[3])) + ((r1[0] * r1[0] + r1[1] * r1[1]) + (r1[2] * r1[2] + r1[3] * r1[3]));
                        const u32x4 w = {cvt_pk_bf16(r0[0], r0[1]), cvt_pk_bf16(r0[2], r0[3]), cvt_pk_bf16(r1[0], r1[1]), cvt_pk_bf16(r1[2], r1[3])};
                        *(u32x4*)((char*)XN + (eh + bj * 128) * 2u) = w;
                    }
                }
                if (WXN) { ss += __shfl_xor(ss, 16); ss += __shfl_xor(ss, 32); if (fq == 0) *(float*)((char*)SSQ + ((unsigned)r * 32 + u.pn * 4 + wc) * 4u) = ss; }
            }
    }
};

template <bool SRC0, bool FINAL>
__device__ __forceinline__ void tail_fix_phase(const Params& p, int nsplit) {
    const int tid = opaque_tid(), lane = tid & 63, wave = tid >> 6;
    float* HO = (float*)(p.ws + WS_HO); bf16_t* XN = (bf16_t*)(p.ws + WS_XN); float* SSQ = (float*)(p.ws + WS_SSQ); const float* SLAB = (const float*)(p.ws + WS_SLAB);
    for (int rr = blockIdx.x; rr < 256; rr += gridDim.x) {
        const int r = 8192 + rr, cols = wave * 256 + lane * 4;
        const float* src = SRC0 ? h0_row(p, r) : HO + (size_t)r * DM;
        f32x4 v = src ? *(const f32x4*)(src + cols) : (f32x4){0.f, 0.f, 0.f, 0.f};
        for (int sidx = 0; sidx < nsplit; ++sidx) v += *(const f32x4*)(SLAB + ((size_t)sidx * 256 + rr) * DM + cols);
        if (FINAL) {
            const int pos = r - LTOT;
            *(f32x4*)(p.out + ((size_t)SEQ + (pos - OFFS)) * DM + cols) = v;
        } else {
            *(f32x4*)(HO + (size_t)r * DM + cols) = v;
            const u32x2 w = {cvt_pk_bf16(v[0], v[1]), cvt_pk_bf16(v[2], v[3])};
            *(u32x2*)(XN + (size_t)r * DM + cols) = w;
            const float ss = wave_sum((v[0] * v[0] + v[1] * v[1]) + (v[2] * v[2] + v[3] * v[3]));
            if (lane == 0) SSQ[(size_t)r * 32 + wave] = ss;
            if (wave == 0 && lane < 24) SSQ[(size_t)r * 32 + 8 + lane] = 0.f;
        }
    }
}

__device__ __forceinline__ void tr_region(LAS unsigned char* lds, const float* __restrict__ W, int pitch, int K, int ncols, const float* __restrict__ gain, bf16_t* dst, int mode, int row_off, int first, int stride) {
    const int tid = opaque_tid();
    const int nN = ncols >> 8, nK = K >> 6, ntl = nN * nK;
    LAS bf16_t* tile = (LAS bf16_t*)lds;
    const int n4 = tid & 63, kq = tid >> 6;
    f32x4 v[8], vn[8];
#define TR_LOAD(dstv, tt) do { const int _kt = (tt) / nN, _nt = (tt) - _kt * nN; \
        _Pragma("unroll") for (int i = 0; i < 8; ++i) dstv[i] = __builtin_nontemporal_load((const f32x4*)(W + (size_t)((_kt << 6) + kq * 8 + i) * pitch + (_nt << 8) + 4 * n4)); } while (0)
    int t = first;
    if (t < ntl) TR_LOAD(v, t);
    for (; t < ntl; t += stride) {
        const int kt = t / nN, ntile = t - kt * nN, k0 = kt << 6, n0 = ntile << 8;
        if (t + stride < ntl) TR_LOAD(vn, t + stride);
        if (gain) {
#pragma unroll
            for (int i = 0; i < 8; ++i) v[i] = v[i] * gain[k0 + kq * 8 + i];
        }
#pragma unroll
        for (int j = 0; j < 4; ++j) {
            const u32x4 o = {cvt_pk_bf16(v[0][j], v[1][j]), cvt_pk_bf16(v[2][j], v[3][j]), cvt_pk_bf16(v[4][j], v[5][j]), cvt_pk_bf16(v[6][j], v[7][j])};
            *(LAS u32x4*)(tile + (4 * n4 + j) * 72 + kq * 8) = o;
        }
        __syncthreads();
#pragma unroll
        for (int i = 0; i < 4; ++i) {
            const int q = tid + 512 * i, n = q >> 3, ch = q & 7;
            const u32x4 o = *(LAS u32x4*)(tile + n * 72 + ch * 8);
            const int nn = n0 + n;
            const int row = mode == 0 ? row_off + nn : ((nn >> 7) * 256 + (mode == 2 ? 128 : 0) + (nn & 127));
            *(u32x4*)(dst + (size_t)row * K + k0 + ch * 8) = o;
        }
        __syncthreads();
#pragma unroll
        for (int i = 0; i < 8; ++i) v[i] = vn[i];
    }
#undef TR_LOAD
}
__device__ __forceinline__ void tr_deferred(const Params& p, LAS unsigned char* lds, int first, int stride, int groups) {
    unsigned char* ws = p.ws;
    if (groups & 1) {
        tr_region(lds, p.w_out_a, 2048, 2048, 2048, nullptr, (bf16_t*)(ws + WS_WOUTA), 0, 0, first, stride);
        tr_region(lds, p.w_ffn_gate, DFF, 2048, DFF, p.g_ffn_norm, (bf16_t*)(ws + WS_WF0), 1, 0, first, stride);
        tr_region(lds, p.w_ffn_up, DFF, 2048, DFF, p.g_ffn_norm, (bf16_t*)(ws + WS_WF0), 2, 0, first, stride);
        tr_region(lds, p.w_ffn_down, 2048, DFF, 2048, nullptr, (bf16_t*)(ws + WS_WD0), 0, 0, first, stride);
    }
    if (groups & 2) {
        tr_region(lds, p.w_kv, 4096, 2048, 4096, p.g_kv_norm, (bf16_t*)(ws + WS_WKVQ), 0, 0, first, stride);
        tr_region(lds, p.w_q_b, 2048, 2048, 2048, p.g_norm_b, (bf16_t*)(ws + WS_WKVQ), 0, 4096, first, stride);
        tr_region(lds, p.w_o_b, 2048, 2048, 2048, nullptr, (bf16_t*)(ws + WS_WOB), 0, 0, first, stride);
    }
    if (groups & 4) {
        tr_region(lds, p.w_ffn_gate + (size_t)2048 * DFF, DFF, 2048, DFF, p.g_ffn_norm + 2048, (bf16_t*)(ws + WS_WF1), 1, 0, first, stride);
        tr_region(lds, p.w_ffn_up + (size_t)2048 * DFF, DFF, 2048, DFF, p.g_ffn_norm + 2048, (bf16_t*)(ws + WS_WF1), 2, 0, first, stride);
        tr_region(lds, p.w_ffn_down + (size_t)DFF * 2048, 2048, DFF, 2048, nullptr, (bf16_t*)(ws + WS_WD1), 0, 0, first, stride);
    }
}

template <bool FIRST>
__device__ __forceinline__ void norm_phase(const Params& p, LAS unsigned char* lds) {
    const int tid = opaque_tid(), lane = tid & 63, wave = tid >> 6;
    bf16_t* XN = (bf16_t*)(p.ws + WS_XN);
    const float* HO = (const float*)(p.ws + WS_HO);
    float* AG = (float*)(p.ws + WS_AG);
    LAS float* wl = (LAS float*)lds;
    if (FIRST) {
        for (int e = tid; e < 2048 * 16; e += 512) { const int k = e >> 4, j = e & 15; wl[j * 2048 + k] = p.g_norm_a[k] * p.w_in_a[(size_t)k * NIN + 6144 + j]; }
        __syncthreads();
    }
    const int gw = blockIdx.x * 8 + wave, ngw = gridDim.x * 8;
    for (int r = gw; r < MTOT; r += ngw) {
        const float* src = FIRST ? h0_row(p, r) : HO + (size_t)r * DM;
        f32x4 v[8];
        float ss = 0.f;
#pragma unroll
        for (int j = 0; j < 8; ++j) {
            v[j] = src ? ((const f32x4*)src)[lane + 64 * j] : (f32x4){0.f, 0.f, 0.f, 0.f};
            ss += (v[j][0] * v[j][0] + v[j][1] * v[j][1]) + (v[j][2] * v[j][2] + v[j][3] * v[j][3]);
        }
        const float rstd = rsqrtf(wave_sum(ss) * (1.f / DM) + EPS);
#pragma unroll
        for (int j = 0; j < 8; ++j) {
            v[j] = v[j] * rstd;
            u32x2 o = {cvt_pk_bf16(v[j][0], v[j][1]), cvt_pk_bf16(v[j][2], v[j][3])};
            ((u32x2*)(XN + (size_t)r * DM))[lane + 64 * j] = o;
        }
        if (FIRST) {
            float a16[16];
#pragma unroll
            for (int jj = 0; jj < 16; ++jj) {
                float a = 0.f;
#pragma unroll
                for (int j = 0; j < 8; ++j) { const f32x4 w4 = *(const LAS f32x4*)(wl + jj * 2048 + 4 * (lane + 64 * j)); a += (v[j][0] * w4[0] + v[j][1] * w4[1]) + (v[j][2] * w4[2] + v[j][3] * w4[3]); }
                a16[jj] = a;
            }
            float b8[8], c4[4], d2[2];
            const bool h32 = lane & 32, h16 = lane & 16, h8 = lane & 8, h4 = lane & 4;
#pragma unroll
            for (int j = 0; j < 8; ++j) { const float mine = h32 ? a16[j + 8] : a16[j], other = h32 ? a16[j] : a16[j + 8]; b8[j] = mine + __shfl_xor(other, 32); }
#pragma unroll
            for (int j = 0; j < 4; ++j) { const float mine = h16 ? b8[j + 4] : b8[j], other = h16 ? b8[j] : b8[j + 4]; c4[j] = mine + __shfl_xor(other, 16); }
#pragma unroll
            for (int j = 0; j < 2; ++j) { const float mine = h8 ? c4[j + 2] : c4[j], other = h8 ? c4[j] : c4[j + 2]; d2[j] = mine + __shfl_xor(other, 8); }
            float e1 = (h4 ? d2[1] : d2[0]) + __shfl_xor(h4 ? d2[0] : d2[1], 4);
            e1 += __shfl_xor(e1, 2); e1 += __shfl_xor(e1, 1);
            if ((lane & 3) == 0) AG[(size_t)r * 16 + (lane >> 2)] = e1;
        }
    }
}

__device__ __forceinline__ void knorm_phase(const Params& p) {
    const int tid = opaque_tid(), lane = tid & 63, wave = tid >> 6;
    bf16_t* KR = (bf16_t*)(p.ws + WS_KR);
    const int gw = blockIdx.x * 8 + wave, ngw = gridDim.x * 8;
    for (int r = gw; r < MTOT; r += ngw) {
#pragma unroll
        for (int i = 0; i < 4; ++i) {
            const int ch = lane + 64 * i;
            u32x4 w = ((const u32x4*)(KR + (size_t)r * DM))[ch];
            float f[8] = {bf_lo(w[0]), bf_hi(w[0]), bf_lo(w[1]), bf_hi(w[1]), bf_lo(w[2]), bf_hi(w[2]), bf_lo(w[3]), bf_hi(w[3])};
            float ss = 0.f;
#pragma unroll
            for (int e = 0; e < 8; ++e) ss += f[e] * f[e];
            ss += __shfl_xor(ss, 1); ss += __shfl_xor(ss, 2); ss += __shfl_xor(ss, 4); ss += __shfl_xor(ss, 8);
            const float rstd = rsqrtf(ss * (1.f / 128.f) + EPS);
            const int d0 = (ch & 15) * 8;
            const f32x4 ga = *(const f32x4*)(p.g_k + d0), gb = *(const f32x4*)(p.g_k + d0 + 4);
            u32x4 o = {cvt_pk_bf16(f[0] * rstd * ga[0], f[1] * rstd * ga[1]), cvt_pk_bf16(f[2] * rstd * ga[2], f[3] * rstd * ga[3]),
                       cvt_pk_bf16(f[4] * rstd * gb[0], f[5] * rstd * gb[1]), cvt_pk_bf16(f[6] * rstd * gb[2], f[7] * rstd * gb[3])};
            ((u32x4*)(KR + (size_t)r * DM))[ch] = o;
        }
    }
}

__device__ __forceinline__ void gla_intra_phase(const Params& p, LAS unsigned char* lds, int u_first, int u_end, int u_stride) {
    const int tid = opaque_tid(), lane = tid & 63, wave = __builtin_amdgcn_readfirstlane(tid >> 6), fr = lane & 15, fq = lane >> 4;
    bf16_t* QA = (bf16_t*)(p.ws + WS_QA); const bf16_t* KA = (const bf16_t*)(p.ws + WS_KA); const bf16_t* VTA = (const bf16_t*)(p.ws + WS_VTA);
    bf16_t* KST = (bf16_t*)(p.ws + WS_KST); float* HO = (float*)(p.ws + WS_HO); float* DCB = (float*)(p.ws + WS_DC); const float* AG = (const float*)(p.ws + WS_AG);
    constexpr int OPS = 264;
    LAS bf16_t* QLO = (LAS bf16_t*)lds; LAS bf16_t* KLO = QLO + 64 * OPS; LAS bf16_t* QUP = KLO + 64 * OPS; LAS bf16_t* KUP = QUP + 64 * OPS;
    LAS bf16_t* PS = KUP + 64 * OPS;
    LAS bf16_t* VT = (LAS bf16_t*)lds;
    LAS float* PART = (LAS float*)(lds + 144384);
    for (int u = u_first; u < u_end; u += u_stride) {
        const int b = u / 264, rem = u - b * 264, c = rem >> 2, h = rem & 3;
        const int r0 = b * LTOT + c * 64;
        {
            const int dp = tid & 127, rq = __builtin_amdgcn_readfirstlane(tid >> 7), dcol = h * 256 + 2 * dp;
            float w0[16], w1[16];
#pragma unroll
            for (int rr = 0; rr < 16; ++rr) { const f32x2_t t = *(const f32x2_t*)(p.w_gate_up_a + rr * GKD + dcol); w0[rr] = t[0]; w1[rr] = t[1]; }
            const f32x2_t bg = *(const f32x2_t*)(p.b_gate_a + dcol);
            float bc0[16], bc1[16]; float run0 = 0.f, run1 = 0.f;
#pragma unroll
            for (int sI = 0; sI < 16; ++sI) {
                const float* ar = AG + (size_t)(r0 + rq * 16 + sI) * 16;
                float x0 = bg[0], x1 = bg[1];
#pragma unroll
                for (int rr = 0; rr < 16; ++rr) { const float av = ar[rr]; x0 += av * w0[rr]; x1 += av * w1[rr]; }
                run0 += log_sigmoid_f(x0) * 0.0625f; run1 += log_sigmoid_f(x1) * 0.0625f;
                bc0[sI] = run0; bc1[sI] = run1;
            }
            *(LAS f32x2_t*)(PART + rq * 256 + 2 * dp) = (f32x2_t){run0, run1};
            __syncthreads();
            const f32x2_t t0 = *(const LAS f32x2_t*)(PART + 2 * dp), t1 = *(const LAS f32x2_t*)(PART + 256 + 2 * dp), t2 = *(const LAS f32x2_t*)(PART + 512 + 2 * dp), t3 = *(const LAS f32x2_t*)(PART + 768 + 2 * dp);
            const float ref0 = t0[0] + t1[0], ref1 = t0[1] + t1[1];
            const float bl0 = ref0 + t2[0] + t3[0], bl1 = ref1 + t2[1] + t3[1];
            const float pre0 = (rq > 0 ? t0[0] : 0.f) + (rq > 1 ? t1[0] : 0.f) + (rq > 2 ? t2[0] : 0.f);
            const float pre1 = (rq > 0 ? t0[1] : 0.f) + (rq > 1 ? t1[1] : 0.f) + (rq > 2 ? t2[1] : 0.f);
            unsigned kst0[8], kst1[8];
#pragma unroll
            for (int sI = 0; sI < 16; ++sI) {
                const int rl = rq * 16 + sI;
                const size_t gofs = (size_t)(r0 + rl) * GKD + dcol;
                const unsigned qraw = *(const unsigned*)(QA + gofs), kraw = *(const unsigned*)(KA + gofs);
                const float q0 = bf_lo(qraw), q1 = bf_hi(qraw), k0 = bf_lo(kraw), k1 = bf_hi(kraw);
                const float v0 = bc0[sI] + pre0, v1 = bc1[sI] + pre1;
                const float e10 = __expf(v0 - ref0), e11 = __expf(v1 - ref1), e20 = __expf(ref0 - v0), e21 = __expf(ref1 - v1);
                *(LAS unsigned*)(QLO + rl * OPS + 2 * dp) = cvt_pk_bf16_v(q0 * e10, q1 * e11);
                *(LAS unsigned*)(KUP + rl * OPS + 2 * dp) = cvt_pk_bf16_v(k0 * e10, k1 * e11);
                *(LAS unsigned*)(QUP + rl * OPS + 2 * dp) = cvt_pk_bf16_v(q0 * e20, q1 * e21);
                *(LAS unsigned*)(KLO + rl * OPS + 2 * dp) = cvt_pk_bf16_v(k0 * e20, k1 * e21);
                *(unsigned*)(QA + gofs) = cvt_pk_bf16_v(q0 * __expf(v0), q1 * __expf(v1));
                const float ks0 = k0 * __expf(bl0 - v0), ks1 = k1 * __expf(bl1 - v1);
                if (sI & 1) { kst0[sI >> 1] = cvt_pk_bf16_v(bf_lo(kst0[sI >> 1]), ks0); kst1[sI >> 1] = cvt_pk_bf16_v(bf_lo(kst1[sI >> 1]), ks1); }
                else { kst0[sI >> 1] = cvt_pk_bf16_v(ks0, 0.f); kst1[sI >> 1] = cvt_pk_bf16_v(ks1, 0.f); }
            }
            bf16_t* kd = KST + (size_t)u * 16384 + (size_t)(2 * dp) * 64 + rq * 16;
            *(u32x4*)(kd) = (u32x4){kst0[0], kst0[1], kst0[2], kst0[3]}; *(u32x4*)(kd + 8) = (u32x4){kst0[4], kst0[5], kst0[6], kst0[7]};
            *(u32x4*)(kd + 64) = (u32x4){kst1[0], kst1[1], kst1[2], kst1[3]}; *(u32x4*)(kd + 72) = (u32x4){kst1[4], kst1[5], kst1[6], kst1[7]};
            if (rq == 0) *(f32x2_t*)(DCB + u * 256 + 2 * dp) = (f32x2_t){__expf(bl0), __expf(bl1)};
        }
        __syncthreads();
        u32x4 vreg[8];
#pragma unroll
        for (int i = 0; i < 8; ++i) { const int ch = tid + 512 * i, dv = ch >> 3, part = ch & 7; vreg[i] = *(const u32x4*)(VTA + ((size_t)((b * 4 + h) * 512 + dv)) * LTOT + c * 64 + part * 8); }
#pragma unroll
        for (int bi = 0; bi < 2; ++bi) {
            const int blk = wave * 2 + bi, tb = blk >> 2, sb = blk & 3;
            f32x4 lo = {0.f, 0.f, 0.f, 0.f}, up = {0.f, 0.f, 0.f, 0.f};
            if (tb >= sb) {
#pragma unroll
                for (int ks = 0; ks < 8; ++ks) {
                    const bf16x8 af = *(const LAS bf16x8*)(QLO + (tb * 16 + fr) * OPS + ks * 32 + fq * 8), bf = *(const LAS bf16x8*)(KLO + (sb * 16 + fr) * OPS + ks * 32 + fq * 8);
                    lo = __builtin_amdgcn_mfma_f32_16x16x32_bf16(af, bf, lo, 0, 0, 0);
                }
            }
            if (tb <= sb) {
#pragma unroll
                for (int ks = 0; ks < 8; ++ks) {
                    const bf16x8 af = *(const LAS bf16x8*)(QUP + (tb * 16 + fr) * OPS + ks * 32 + fq * 8), bf = *(const LAS bf16x8*)(KUP + (sb * 16 + fr) * OPS + ks * 32 + fq * 8);
                    up = __builtin_amdgcn_mfma_f32_16x16x32_bf16(af, bf, up, 0, 0, 0);
                }
            }
#pragma unroll
            for (int i = 0; i < 4; ++i) {
                const int t = tb * 16 + fq * 4 + i, s = sb * 16 + fr;
                const float val = (t >= s) ? lo[i] : up[i];
                PS[t * 72 + s] = (bf16_t)(cvt_pk_bf16_v(val, 0.f) & 0xffffu);
            }
        }
        __syncthreads();
#pragma unroll
        for (int i = 0; i < 8; ++i) { const int ch = tid + 512 * i, dv = ch >> 3, part = ch & 7; *(LAS u32x4*)(VT + dv * 72 + part * 8) = vreg[i]; }
        __syncthreads();
#pragma unroll
        for (int tb = 0; tb < 4; ++tb) {
            const bf16x8 a0 = *(const LAS bf16x8*)(PS + (tb * 16 + fr) * 72 + fq * 8), a1 = *(const LAS bf16x8*)(PS + (tb * 16 + fr) * 72 + 32 + fq * 8);
#pragma unroll
            for (int j = 0; j < 4; ++j) {
                const int dvb = wave * 4 + j;
                const bf16x8 b0 = *(const LAS bf16x8*)(VT + (dvb * 16 + fr) * 72 + fq * 8), b1 = *(const LAS bf16x8*)(VT + (dvb * 16 + fr) * 72 + 32 + fq * 8);
                f32x4 o = {0.f, 0.f, 0.f, 0.f};
                o = __builtin_amdgcn_mfma_f32_16x16x32_bf16(a0, b0, o, 0, 0, 0);
                o = __builtin_amdgcn_mfma_f32_16x16x32_bf16(a1, b1, o, 0, 0, 0);
#pragma unroll
                for (int i = 0; i < 4; ++i) HO[(size_t)(r0 + tb * 16 + fq * 4 + i) * DM + h * 512 + dvb * 16 + fr] = o[i];
            }
        }
        __syncthreads();
    }
}

__device__ __forceinline__ void gla_scan_phase(const Params& p, LAS unsigned char* lds) {
    constexpr int LEFT_CNT = 3520;
    unsigned* barw = (unsigned*)(p.ws + WS_BAR);
    if (blockIdx.x >= 128) {
        if (gridDim.x == 256) {
            if (blockIdx.x < 144) {
                gla_intra_phase(p, lds, 512 + (int)blockIdx.x - 128, 528, 1 << 20);
                asm volatile("s_waitcnt vmcnt(0)" ::: "memory");
                __syncthreads();
                if (threadIdx.x == 0) { __builtin_amdgcn_fence(__ATOMIC_RELEASE, "agent"); asm volatile("s_waitcnt vmcnt(0)" ::: "memory"); (void)xb_add(&barw[LEFT_CNT], 1u); }
            }
            tr_deferred(p, lds, (int)blockIdx.x - 128, 128, 2);
        }
        return;
    }
    const int tid = opaque_tid(), lane = tid & 63, wave = __builtin_amdgcn_readfirstlane(tid >> 6), fr = lane & 15, fq = lane >> 4;
    const int id = blockIdx.x, bh = id & 7, sl = id >> 3, b = bh >> 2, h = bh & 3, dv0 = sl * 32;
    const bf16_t* QA = (const bf16_t*)(p.ws + WS_QA); const bf16_t* VTA = (const bf16_t*)(p.ws + WS_VTA); const bf16_t* KST = (const bf16_t*)(p.ws + WS_KST);
    bf16_t* OI = (bf16_t*)(p.ws + WS_XN); const float* DCB = (const float*)(p.ws + WS_DC);
    LAS bf16_t* QI_s0 = (LAS bf16_t*)lds;
    LAS bf16_t* VT_s0 = (LAS bf16_t*)(lds + 67584);
    LAS float* DC_s0 = (LAS float*)(lds + 76800);
    LAS bf16_t* ST_s = (LAS bf16_t*)(lds + 78848);
    for (int e = tid; e < 32 * 264 / 2; e += 512) ((LAS unsigned*)ST_s)[e] = 0u;
    f32x4 S[2][2];
#pragma unroll
    for (int i = 0; i < 2; ++i)
#pragma unroll
        for (int j = 0; j < 2; ++j) S[i][j] = (f32x4){0.f, 0.f, 0.f, 0.f};
    const int tb = wave & 3, vb = wave >> 2;
    const bf16_t* kbase = KST + (size_t)(b * 264 + h) * 16384 + (size_t)(wave * 32 + fr) * 64 + fq * 8;
    u32x4 rqA[4], rvA = {0u, 0u, 0u, 0u}; bf16x8 kfA[2][2]; f32x4 rdcA = {0.f, 0.f, 0.f, 0.f}; float hoA[4];
    u32x4 rqB[4], rvB = {0u, 0u, 0u, 0u}; bf16x8 kfB[2][2]; f32x4 rdcB = {0.f, 0.f, 0.f, 0.f}; float hoB[4];
#define GLA_ISSUE(rq, kf, rv, rdc, ho, cstep) do { const int _c = (cstep); const int _r0 = b * LTOT + _c * 64; const int _u = b * 264 + _c * 4 + h; \
        _Pragma("unroll") for (int i = 0; i < 4; ++i) { const int ch = tid + 512 * i; rq[i] = *(const u32x4*)(QA + (size_t)(_r0 + (ch >> 5)) * GKD + h * 256 + (ch & 31) * 8); } \
        _Pragma("unroll") for (int di = 0; di < 2; ++di) { _Pragma("unroll") for (int ks = 0; ks < 2; ++ks) kf[di][ks] = *(const bf16x8*)(kbase + (size_t)_c * 65536 + di * 1024 + ks * 32); } \
        rv = *(const u32x4*)(VTA + ((size_t)((b * 4 + h) * 512 + dv0 + ((tid & 255) >> 3))) * LTOT + _c * 64 + (tid & 7) * 8); \
        rdc = ((const f32x4*)(DCB + _u * 256))[tid & 63]; \
        (void)ho; } while (0)
#define GLA_STEP(rq, kf, rv, rdc, ho, cstep) do { const int c = (cstep); const int cur = c & 1; \
        if (c == 60 && b == 1 && gridDim.x == 256) {     \
            if (threadIdx.x == 0) { XB_SPIN(xb_ld(&barw[LEFT_CNT]) < 16u, barw); __builtin_amdgcn_fence(__ATOMIC_ACQUIRE, "agent"); asm volatile("s_waitcnt vmcnt(0)" ::: "memory"); } \
            __syncthreads(); } \
        LAS bf16_t* QI_s = QI_s0 + cur * (64 * 264); LAS bf16_t* VT_s = VT_s0 + cur * (32 * 72); LAS float* DC_s = DC_s0 + cur * 256; \
        _Pragma("unroll") for (int i = 0; i < 4; ++i) { const int ch = tid + 512 * i; *(LAS u32x4*)(QI_s + (ch >> 5) * 264 + (ch & 31) * 8) = rq[i]; } \
        if (tid < 256) *(LAS u32x4*)(VT_s + (tid >> 3) * 72 + (tid & 7) * 8) = rv; \
        if (tid < 64) *(LAS f32x4*)(DC_s + tid * 4) = rdc; \
        const bf16x8 k00 = kf[0][0], k01 = kf[0][1], k10 = kf[1][0], k11 = kf[1][1]; \
        const int r0 = b * LTOT + c * 64; \
        GLA_ISSUE(rq, kf, rv, rdc, ho, (c + 2 < 66 ? c + 2 : 65));     \
        __syncthreads(); \
        { f32x4 o = {0.f, 0.f, 0.f, 0.f}; \
          LAS const bf16_t* st = ST_s + cur * (32 * 264); \
          _Pragma("unroll") for (int ks = 0; ks < 8; ++ks) { \
              const bf16x8 af = *(const LAS bf16x8*)(QI_s + (tb * 16 + fr) * 264 + ks * 32 + fq * 8), bf = *(const LAS bf16x8*)(st + (vb * 16 + fr) * 264 + ks * 32 + fq * 8); \
              o = __builtin_amdgcn_mfma_f32_16x16x32_bf16(af, bf, o, 0, 0, 0); } \
            \
          _Pragma("unroll") for (int i = 0; i < 4; ++i) OI[(size_t)(r0 + tb * 16 + fq * 4 + i) * DM + h * 512 + dv0 + vb * 16 + fr] = (bf16_t)(cvt_pk_bf16_v(o[i], 0.f) & 0xffffu); } \
        { LAS bf16_t* stn = ST_s + (cur ^ 1) * (32 * 264); \
          _Pragma("unroll") for (int di = 0; di < 2; ++di) { \
              const int db = wave * 2 + di; \
              const f32x4 dc = *(const LAS f32x4*)(DC_s + db * 16 + fq * 4); \
              const bf16x8 a0 = di ? k10 : k00, a1 = di ? k11 : k01; \
              _Pragma("unroll") for (int vj = 0; vj < 2; ++vj) { \
                  const bf16x8 b0 = *(const LAS bf16x8*)(VT_s + (vj * 16 + fr) * 72 + fq * 8), b1 = *(const LAS bf16x8*)(VT_s + (vj * 16 + fr) * 72 + 32 + fq * 8); \
                  f32x4 sv = S[di][vj] * dc; \
                  sv = __builtin_amdgcn_mfma_f32_16x16x32_bf16(a0, b0, sv, 0, 0, 0); \
                  sv = __builtin_amdgcn_mfma_f32_16x16x32_bf16(a1, b1, sv, 0, 0, 0); \
                  S[di][vj] = sv; \
                  const u32x2 wv = {cvt_pk_bf16_v(sv[0], sv[1]), cvt_pk_bf16_v(sv[2], sv[3])}; \
                  *(LAS u32x2*)(stn + (vj * 16 + fr) * 264 + db * 16 + fq * 4) = wv; } } } \
        } while (0)
    GLA_ISSUE(rqA, kfA, rvA, rdcA, hoA, 0);
    GLA_ISSUE(rqB, kfB, rvB, rdcB, hoB, 1);
#pragma unroll 11
    for (int cc = 0; cc < 66; cc += 2) {
        GLA_STEP(rqA, kfA, rvA, rdcA, hoA, cc);
        GLA_STEP(rqB, kfB, rvB, rdcB, hoB, cc + 1);
    }
    __syncthreads();
#undef GLA_STEP
#undef GLA_ISSUE
}

__device__ __forceinline__ void gla_out_phase(const Params& p) {
    const int tid = opaque_tid(), lane = tid & 63, wave = tid >> 6;
    const float* HO = (const float*)(p.ws + WS_HO); const bf16_t* GA = (const bf16_t*)(p.ws + WS_GA); bf16_t* OG = (bf16_t*)(p.ws + WS_OG);
    const bf16_t* OI = (const bf16_t*)(p.ws + WS_XN);
    const int gw = blockIdx.x * 8 + wave, ngw = gridDim.x * 8;
    for (int it = gw; it < MTOT * 4; it += ngw) {
        const int r = it >> 2, h = it & 3;
        const size_t base = (size_t)r * DM + h * 512 + lane * 8;
        f32x4 o0 = *(const f32x4*)(HO + base), o1 = *(const f32x4*)(HO + base + 4);
        { const u32x4 oi = *(const u32x4*)(OI + base); o0[0] += bf_lo(oi[0]); o0[1] += bf_hi(oi[0]); o0[2] += bf_lo(oi[1]); o0[3] += bf_hi(oi[1]); o1[0] += bf_lo(oi[2]); o1[1] += bf_hi(oi[2]); o1[2] += bf_lo(oi[3]); o1[3] += bf_hi(oi[3]); }
        float ss = (o0[0] * o0[0] + o0[1] * o0[1]) + (o0[2] * o0[2] + o0[3] * o0[3]) + (o1[0] * o1[0] + o1[1] * o1[1]) + (o1[2] * o1[2] + o1[3] * o1[3]);
        const float rstd = rsqrtf(wave_sum(ss) * (1.f / 512.f) + EPS);
        const f32x4 g0 = *(const f32x4*)(p.g_onorm_a + lane * 8), g1 = *(const f32x4*)(p.g_onorm_a + lane * 8 + 4);
        const u32x4 gw4 = *(const u32x4*)(GA + base);
        u32x4 w = {cvt_pk_bf16_v(o0[0] * rstd * g0[0] * bf_lo(gw4[0]), o0[1] * rstd * g0[1] * bf_hi(gw4[0])), cvt_pk_bf16_v(o0[2] * rstd * g0[2] * bf_lo(gw4[1]), o0[3] * rstd * g0[3] * bf_hi(gw4[1])),
                   cvt_pk_bf16_v(o1[0] * rstd * g1[0] * bf_lo(gw4[2]), o1[1] * rstd * g1[1] * bf_hi(gw4[2])), cvt_pk_bf16_v(o1[2] * rstd * g1[2] * bf_lo(gw4[3]), o1[3] * rstd * g1[3] * bf_hi(gw4[3]))};
        *(u32x4*)(OG + base) = w;
    }
}

__device__ __forceinline__ void attn_phase(const Params& p, LAS unsigned char* lds) {
    const int tid = opaque_tid(), lane = tid & 63, wave = __builtin_amdgcn_readfirstlane(tid >> 6), r = lane & 31, hh = lane >> 5;
    const bf16_t* QR = (const bf16_t*)(p.ws + WS_QR); const bf16_t* KN = (const bf16_t*)(p.ws + WS_KR); const bf16_t* VTB = (const bf16_t*)(p.ws + WS_VTB);
    bf16_t* OB = (bf16_t*)(p.ws + WS_OB);
    LAS bf16_t* K_s = (LAS bf16_t*)lds;
    LAS bf16_t* V_s = (LAS bf16_t*)(lds + 17408);
    LAS int* FLG = (LAS int*)(lds + 17408 + 18432);
    float gk[8];
    { const f32x4 ga = *(const f32x4*)(p.g_k + (tid & 15) * 8), gb = *(const f32x4*)(p.g_k + (tid & 15) * 8 + 4);
      gk[0] = ga[0]; gk[1] = ga[1]; gk[2] = ga[2]; gk[3] = ga[3]; gk[4] = gb[0]; gk[5] = gb[1]; gk[6] = gb[2]; gk[7] = gb[3]; }
    bf16x8 Tf[2];
#pragma unroll
    for (int s = 0; s < 2; ++s)
#pragma unroll
        for (int j = 0; j < 8; ++j) { const int key = 16 * s + 8 * (j >> 2) + 4 * hh + (j & 3); Tf[s][j] = (key >= r) ? (short)0x3F80 : (short)0; }
    for (int it = blockIdx.x; it < 544; it += gridDim.x) {
        int qb; if (it < 256) qb = 16 - (it >> 5); else if (it < 512) qb = 1 + ((it - 256) >> 5); else qb = 0;
        const int bhh = it & 31, b = bhh >> 4, h = bhh & 15;
        const int q0 = -128 + 256 * qb;
        const int qpos = q0 + 32 * wave + r;
        const int qmax_w = q0 + 32 * wave + 31;
        const bool wact = qmax_w >= PADN;
        bf16x8 qf[8];
        if (wact) {
            u32x4 raw[8]; float ss = 0.f;
#pragma unroll
            for (int ks = 0; ks < 8; ++ks) {
                raw[ks] = *(const u32x4*)(QR + (size_t)(b * LTOT + qpos) * DM + h * 128 + 16 * ks + 8 * hh);
#pragma unroll
                for (int e = 0; e < 4; ++e) { const float lo = bf_lo(raw[ks][e]), hi = bf_hi(raw[ks][e]); ss += lo * lo + hi * hi; }
            }
            ss += __shfl_xor(ss, 32);
            const float sc = rsqrtf(ss * (1.f / 128.f) + EPS) * 0.08838834764831845f;
#pragma unroll
            for (int ks = 0; ks < 8; ++ks) {
                const f32x4 ga = *(const f32x4*)(p.g_q_b + 16 * ks + 8 * hh), gb = *(const f32x4*)(p.g_q_b + 16 * ks + 8 * hh + 4);
                u32x4 w = {cvt_pk_bf16_v(bf_lo(raw[ks][0]) * sc * ga[0], bf_hi(raw[ks][0]) * sc * ga[1]), cvt_pk_bf16_v(bf_lo(raw[ks][1]) * sc * ga[2], bf_hi(raw[ks][1]) * sc * ga[3]),
                           cvt_pk_bf16_v(bf_lo(raw[ks][2]) * sc * gb[0], bf_hi(raw[ks][2]) * sc * gb[1]), cvt_pk_bf16_v(bf_lo(raw[ks][3]) * sc * gb[2], bf_hi(raw[ks][3]) * sc * gb[3])};
                qf[ks] = __builtin_bit_cast(bf16x8, w);
            }
        } else {
#pragma unroll
            for (int ks = 0; ks < 8; ++ks) qf[ks] = (bf16x8){0, 0, 0, 0, 0, 0, 0, 0};
        }
        f32x16 O[4];
#pragma unroll
        for (int d = 0; d < 4; ++d)
#pragma unroll
            for (int i = 0; i < 16; ++i) O[d][i] = 0.f;
        float carry = 0.f;
        bool wdone = !wact;
        const int kt_hi = (q0 + 254) >> 6;
        u32x4 rkk[2], rvv[2];
#define ATT_ISSUE(ktile) do { const int _k0 = (ktile) * 64; \
        _Pragma("unroll") for (int i = 0; i < 2; ++i) { const int ch = tid + 512 * i; \
            rkk[i] = *(const u32x4*)(KN + (size_t)(b * LTOT + _k0 + (ch >> 4)) * DM + h * 128 + (ch & 15) * 8); \
            rvv[i] = *(const u32x4*)(VTB + ((size_t)((b * 16 + h) * 128 + (ch >> 3))) * LTOT + _k0 + (ch & 7) * 8); } } while (0)
        ATT_ISSUE(kt_hi);
        for (int kt = kt_hi; kt >= 1; --kt) {
#pragma unroll
            for (int i = 0; i < 2; ++i) { const int ch = tid + 512 * i;
                const u32x4 w = rkk[i];
                float f[8] = {bf_lo(w[0]), bf_hi(w[0]), bf_lo(w[1]), bf_hi(w[1]), bf_lo(w[2]), bf_hi(w[2]), bf_lo(w[3]), bf_hi(w[3])};
                float ss = 0.f;
#pragma unroll
                for (int e = 0; e < 8; ++e) ss += f[e] * f[e];
                ss += __shfl_xor(ss, 1); ss += __shfl_xor(ss, 2); ss += __shfl_xor(ss, 4); ss += __shfl_xor(ss, 8);
                const float rs = rsqrtf(ss * (1.f / 128.f) + EPS);
                const u32x4 o = {cvt_pk_bf16_v(f[0] * rs * gk[0], f[1] * rs * gk[1]), cvt_pk_bf16_v(f[2] * rs * gk[2], f[3] * rs * gk[3]),
                                 cvt_pk_bf16_v(f[4] * rs * gk[4], f[5] * rs * gk[5]), cvt_pk_bf16_v(f[6] * rs * gk[6], f[7] * rs * gk[7])};
                *(LAS u32x4*)(K_s + (ch >> 4) * 136 + (ch & 15) * 8) = o; *(LAS u32x4*)(V_s + (ch >> 3) * 72 + (ch & 7) * 8) = rvv[i]; }
            if (kt > 1) ATT_ISSUE(kt - 1);
            __syncthreads();
            if (!wdone) {
#pragma unroll
                for (int sub = 1; sub >= 0; --sub) {
                    const int kb0 = kt * 64 + sub * 32;
                    if (kb0 <= qmax_w - 1 && kb0 + 31 >= PADN) {
                        f32x16 Z;
#pragma unroll
                        for (int i = 0; i < 16; ++i) Z[i] = 0.f;
#pragma unroll
                        for (int ks = 0; ks < 8; ++ks) {
                            const bf16x8 kf = *(const LAS bf16x8*)(K_s + (sub * 32 + r) * 136 + 16 * ks + 8 * hh);
                            Z = __builtin_amdgcn_mfma_f32_32x32x16_bf16(kf, qf[ks], Z, 0, 0, 0);
                        }
                        float lf[16]; float tot = 0.f; unsigned vmask = 0xffffu;
                        const bool interior = (kb0 + 31 < q0 + 32 * wave) && (kb0 >= PADN);
                        if (interior) {
#pragma unroll
                            for (int i = 0; i < 16; ++i) { lf[i] = log_sigmoid_f(-Z[i]); tot += lf[i]; }
                        } else {
                            vmask = 0u;
#pragma unroll
                            for (int i = 0; i < 16; ++i) {
                                const int key = kb0 + (i & 3) + 8 * (i >> 2) + 4 * hh;
                                const bool valid = (key < qpos) && (key >= PADN);
                                vmask |= valid ? (1u << i) : 0u;
                                lf[i] = valid ? log_sigmoid_f(-Z[i]) : 0.f;
                                tot += lf[i];
                            }
                        }
                        tot += __shfl_xor(tot, 32);
                        f32x16 Y;
#pragma unroll
                        for (int i = 0; i < 16; ++i) Y[i] = 0.f;
#pragma unroll
                        for (int s = 0; s < 2; ++s) {
                            unsigned hi4[4], lo4[4];
#pragma unroll
                            for (int e = 0; e < 4; ++e) {
                                const float x0 = lf[8 * s + 2 * e], x1 = lf[8 * s + 2 * e + 1];
                                const unsigned hw = cvt_pk_bf16_v(x0, x1);
                                hi4[e] = hw; lo4[e] = cvt_pk_bf16_v(x0 - bf_lo(hw), x1 - bf_hi(hw));
                            }
                            const u32x4 hv = {hi4[0], hi4[1], hi4[2], hi4[3]}, lv = {lo4[0], lo4[1], lo4[2], lo4[3]};
                            Y = __builtin_amdgcn_mfma_f32_32x32x16_bf16(Tf[s], __builtin_bit_cast(bf16x8, hv), Y, 0, 0, 0);
                            Y = __builtin_amdgcn_mfma_f32_32x32x16_bf16(Tf[s], __builtin_bit_cast(bf16x8, lv), Y, 0, 0, 0);
                        }
                        float att[16];
#pragma unroll
                        for (int i = 0; i < 16; ++i) att[i] = __expf(Z[i] + Y[i] + carry);
                        if (!interior) {
#pragma unroll
                            for (int i = 0; i < 16; ++i) att[i] = ((vmask >> i) & 1u) ? att[i] : 0.f;
                        }
                        carry += tot;
                        bf16x8 pa[2];
#pragma unroll
                        for (int s = 0; s < 2; ++s) {
                            const u32x4 w = {cvt_pk_bf16_v(att[8 * s], att[8 * s + 1]), cvt_pk_bf16_v(att[8 * s + 2], att[8 * s + 3]), cvt_pk_bf16_v(att[8 * s + 4], att[8 * s + 5]), cvt_pk_bf16_v(att[8 * s + 6], att[8 * s + 7])};
                            pa[s] = __builtin_bit_cast(bf16x8, w);
                        }
#pragma unroll
                        for (int dvb = 0; dvb < 4; ++dvb)
#pragma unroll
                            for (int s = 0; s < 2; ++s) {
                                const u32x2 v0 = *(const LAS u32x2*)(V_s + (dvb * 32 + r) * 72 + sub * 32 + 16 * s + 4 * hh);
                                const u32x2 v1 = *(const LAS u32x2*)(V_s + (dvb * 32 + r) * 72 + sub * 32 + 16 * s + 8 + 4 * hh);
                                const u32x4 vv = {v0[0], v0[1], v1[0], v1[1]};
                                O[dvb] = __builtin_amdgcn_mfma_f32_32x32x16_bf16(__builtin_bit_cast(bf16x8, vv), pa[s], O[dvb], 0, 0, 0);
                            }
                    }
                }
                if (__all(carry < -105.f)) wdone = true;
            }
            if (lane == 0) FLG[wave] = wdone ? 0 : 1;
            __syncthreads();
            const int anyw = FLG[0] | FLG[1] | FLG[2] | FLG[3] | FLG[4] | FLG[5] | FLG[6] | FLG[7];
            if (!anyw) break;
        }
        __syncthreads();
#undef ATT_ISSUE
        if (wact && qpos >= PADN) {
            bf16_t* orow = OB + (size_t)(b * LTOT + qpos) * DM + h * 128;
#pragma unroll
            for (int dvb = 0; dvb < 4; ++dvb)
#pragma unroll
                for (int g = 0; g < 4; ++g) {
                    const u32x2 w = {cvt_pk_bf16_v(O[dvb][4 * g], O[dvb][4 * g + 1]), cvt_pk_bf16_v(O[dvb][4 * g + 2], O[dvb][4 * g + 3])};
                    *(u32x2*)(orow + dvb * 32 + 8 * g + 4 * hh) = w;
                }
        }
    }
}


#define GRID_SYNC() do { asm volatile("s_waitcnt vmcnt(0)" ::: "memory"); grid.sync(); __builtin_amdgcn_fence(__ATOMIC_ACQUIRE, "agent"); asm volatile("s_waitcnt vmcnt(0)" ::: "memory"); } while (0)
__global__ void __launch_bounds__(512, 2) yoco_fwd(Params p) {
    extern __shared__ __attribute__((aligned(16))) unsigned char lds_raw[];
    LAS unsigned char* lds = (LAS unsigned char*)lds_raw;
    cg::grid_group grid = cg::this_grid();
    unsigned char* ws = p.ws;
    bf16_t* XN = (bf16_t*)(ws + WS_XN);
    float* HO = (float*)(ws + WS_HO);
    const int G = gridDim.x, bid = blockIdx.x;
    volatile LAS unsigned* xst = (volatile LAS unsigned*)(lds + LDS_BYTES - 16);
    if (threadIdx.x < 4) xst[threadIdx.x] = 0u;
    __syncthreads();
    XcdBarrier xb; xb.bar = (unsigned*)(p.ws + WS_BAR); xb.x = 0; xb.st = xst;
    if (p.ph_hi - p.ph_lo > 1) xb = xcd_barrier_post((unsigned*)(p.ws + WS_BAR), xst);
    if (p.ph_lo < 0) grid.sync();

#ifndef MK_DUMP
#define MK_DUMP 0
#endif
#ifndef MK_STOP
#define MK_STOP 17
#endif
#ifndef PROF_A
#define PROF_A -1
#endif
#ifndef PROF_B
#define PROF_B -1
#endif
#ifndef PROF_AMP
#define PROF_AMP 8
#endif
    unsigned long long tA0 = 0, tA1 = 0, tB0 = 0, tB1 = 0;
#define PROF_BEGIN(k) do { if ((k) == PROF_A) tA0 = __builtin_amdgcn_s_memrealtime(); if ((k) == PROF_B) tB0 = __builtin_amdgcn_s_memrealtime(); } while (0)
#define PROF_END(k) do { if ((k) == PROF_A) tA1 = __builtin_amdgcn_s_memrealtime(); if ((k) == PROF_B) tB1 = __builtin_amdgcn_s_memrealtime(); } while (0)
#define IN(k) (p.ph_lo <= (k) && (k) < p.ph_hi)
#define BOTH(k) (IN(k) && IN((k) + 1))
    if (IN(0)) { PROF_BEGIN(0);
    tr_region(lds, p.w_in_a, NIN, 2048, 6144, p.g_norm_a, (bf16_t*)(ws + WS_WIN), 0, 0, blockIdx.x, gridDim.x);
    if (gridDim.x != 256) tr_deferred(p, lds, blockIdx.x, gridDim.x, 7);
    norm_phase<true>(p, lds);
        if (BOTH(0)) xcd_barrier(xb);
        PROF_END(0);
    }
    if (IN(1)) { PROF_BEGIN(1);

    {
        pg8::Gemm g{XN, (const bf16_t*)(ws + WS_WIN), MTOT, 6144, 2048}; pg8::StaticOrder S; S.init(MTOT, 6144, 2048, G, bid);
        EpiIn E{(bf16_t*)(ws + WS_QA), (bf16_t*)(ws + WS_KA), (bf16_t*)(ws + WS_VTA), (bf16_t*)(ws + WS_GA), p.ph_hi > 0 ? 1.0f : 0.0f};
        pg8::gemm_phase<EpiIn, pg8::StaticOrder, true, true>(lds, g, S, E);
        if (G == 256 && bid >= 24) tr_deferred(p, lds, bid - 24, 232, 1);
    }
        if (BOTH(1)) xcd_barrier(xb);
        PROF_END(1);
    }
    if (IN(2)) { PROF_BEGIN(2);
    if (G == 256) gla_intra_phase(p, lds, bid, 512, 256);
    else gla_intra_phase(p, lds, bid, 528, G);
        if (BOTH(2)) xcd_barrier(xb);
        PROF_END(2);
    }
    if (IN(3)) { PROF_BEGIN(3);
    gla_scan_phase(p, lds);
        if (BOTH(3)) xcd_barrier(xb);
        PROF_END(3);
    }
    if (IN(4)) { PROF_BEGIN(4);
    gla_out_phase(p);
        if (BOTH(4)) xcd_barrier(xb);
        PROF_END(4);
    }
    if (IN(5)) { PROF_BEGIN(5);
    {
        pg8::Gemm g{(const bf16_t*)(ws + WS_OG), (const bf16_t*)(ws + WS_WOUTA), MTOT, 2048, 2048}; pg8::TailOrder S; S.init(2048, 2048, G, bid, 8);
        EpiRes<true, false, true> E{p.x, p.meta, p.out, HO, XN, (float*)(ws + WS_SSQ), (float*)(ws + WS_SLAB)};
        pg8::gemm_phase<EpiRes<true, false, true>, pg8::TailOrder, true, true>(lds, g, S, E);
    }
        if (BOTH(5)) xcd_barrier(xb);
        PROF_END(5);
    }
    if (IN(6)) { PROF_BEGIN(6);
    tail_fix_phase<true, false>(p, 8);
        if (BOTH(6)) xcd_barrier(xb);
        PROF_END(6);
    }
    if (IN(7)) { PROF_BEGIN(7);
    {
        pg8::Gemm g{XN, (const bf16_t*)(ws + WS_WF0), MTOT, 2 * DFF, 2048}; pg8::StaticOrder S; S.init(MTOT, 2 * DFF, 2048, G, bid);
        EpiSwiglu E{(bf16_t*)(ws + WS_ACT), (const float*)(ws + WS_SSQ)};
        pg8::gemm_phase<EpiSwiglu, pg8::StaticOrder, true, true>(lds, g, S, E);
    }
        if (BOTH(7)) xcd_barrier(xb);
        PROF_END(7);
    }
    if (IN(8)) { PROF_BEGIN(8);
    {
        pg8::Gemm g{(const bf16_t*)(ws + WS_ACT), (const bf16_t*)(ws + WS_WD0), MTOT, 2048, DFF}; pg8::TailOrder S; S.init(2048, DFF, G, bid, 11);
        EpiRes<false, false, true> E{p.x, p.meta, p.out, HO, XN, (float*)(ws + WS_SSQ), (float*)(ws + WS_SLAB)};
        pg8::gemm_phase<EpiRes<false, false, true>, pg8::TailOrder, true, true>(lds, g, S, E);
    }
        if (BOTH(8)) xcd_barrier(xb);
        PROF_END(8);
    }
    if (IN(9)) { PROF_BEGIN(9);
    tail_fix_phase<false, false>(p, 11);
        if (BOTH(9)) xcd_barrier(xb);
        PROF_END(9);
    }
    if (IN(10)) { PROF_BEGIN(10);
    {
        pg8::Gemm g{XN, (const bf16_t*)(ws + WS_WKVQ), MTOT, 6144, 2048}; pg8::StaticOrder S; S.init(MTOT, 6144, 2048, G, bid);
        EpiKvq E{(bf16_t*)(ws + WS_KR), (bf16_t*)(ws + WS_VTB), (bf16_t*)(ws + WS_QR), (const float*)(ws + WS_SSQ)};
        pg8::gemm_phase<EpiKvq, pg8::StaticOrder, true, true>(lds, g, S, E);
        if (G == 256 && bid >= 24) tr_deferred(p, lds, bid - 24, 232, 4);
    }
        if (BOTH(10)) xcd_barrier(xb);
        PROF_END(10);
    }
    if (IN(11)) { PROF_BEGIN(11);
        PROF_END(11);
    }
    if (IN(12)) { PROF_BEGIN(12);
    attn_phase(p, lds);
        if (BOTH(12)) xcd_barrier(xb);
        PROF_END(12);
    }
    if (IN(13)) { PROF_BEGIN(13);
    {
        pg8::Gemm g{(const bf16_t*)(ws + WS_OB), (const bf16_t*)(ws + WS_WOB), MTOT, 2048, 2048}; pg8::TailOrder S; S.init(2048, 2048, G, bid, 8);
        EpiRes<false, false, true> E{p.x, p.meta, p.out, HO, XN, (float*)(ws + WS_SSQ), (float*)(ws + WS_SLAB)};
        pg8::gemm_phase<EpiRes<false, false, true>, pg8::TailOrder, true, true>(lds, g, S, E);
    }
        if (BOTH(13)) xcd_barrier(xb);
        PROF_END(13);
    }
    if (IN(14)) { PROF_BEGIN(14);
    tail_fix_phase<false, false>(p, 8);
        if (BOTH(14)) xcd_barrier(xb);
        PROF_END(14);
    }
    if (IN(15)) { PROF_BEGIN(15);
    {
        pg8::Gemm g{XN, (const bf16_t*)(ws + WS_WF1), MTOT, 2 * DFF, 2048}; pg8::StaticOrder S; S.init(MTOT, 2 * DFF, 2048, G, bid);
        EpiSwiglu E{(bf16_t*)(ws + WS_ACT), (const float*)(ws + WS_SSQ)};
        pg8::gemm_phase<EpiSwiglu, pg8::StaticOrder, true, true>(lds, g, S, E);
    }
        if (BOTH(15)) xcd_barrier(xb);
        PROF_END(15);
    }
    if (IN(16)) { PROF_BEGIN(16);
    {
        pg8::Gemm g{(const bf16_t*)(ws + WS_ACT), (const bf16_t*)(ws + WS_WD1), MTOT, 2048, DFF}; pg8::TailOrder S; S.init(2048, DFF, G, bid, 11);
        EpiRes<false, true, false> E{p.x, p.meta, p.out, HO, XN, (float*)(ws + WS_SSQ), (float*)(ws + WS_SLAB)};
        pg8::gemm_phase<EpiRes<false, true, false>, pg8::TailOrder, true, true>(lds, g, S, E);
    }
        if (BOTH(16)) xcd_barrier(xb);
        PROF_END(16);
    }
    if (IN(17)) { PROF_BEGIN(17);
    tail_fix_phase<false, true>(p, 11);
    }
    if ((PROF_A != -1 || PROF_B != -1) && p.ph_hi == 18) {
        xcd_barrier(xb);
        if (PROF_A == 17) tA1 = __builtin_amdgcn_s_memrealtime();
        if (PROF_B == 17) tB1 = __builtin_amdgcn_s_memrealtime();
        if (blockIdx.x == 0) {
            const int n = PROF_A == 100 ? 1000 : (PROF_A >= 0 ? (int)((tA1 - tA0) / 100ull) : 0);
            for (int i = opaque_tid(); i < n; i += 512) p.out[(size_t)i * 163 + 7] += 0.2f;
            if (PROF_B >= 0) { const unsigned long long until = __builtin_amdgcn_s_memrealtime() + (tB1 - tB0) * (unsigned long long)PROF_AMP; while (__builtin_amdgcn_s_memrealtime() < until) __builtin_amdgcn_s_sleep(8); }
        }
    }
    if (IN(18)) {
        const int gt = blockIdx.x * 512 + opaque_tid(), ngt = gridDim.x * 512;
        for (size_t i = gt; i < (size_t)BATCH * SEQ * DM; i += ngt) {
            const size_t row = i / DM, c = i - row * DM; const size_t b = row / SEQ, t = row - b * SEQ; const size_t src = (b * LTOT + OFFS + t) * DM + c;
            float v;
            if (MK_DUMP == 0) v = HO[src];
            else if (MK_DUMP == 1) v = bf_lo((unsigned)XN[src]);
            else v = bf_lo((unsigned)((const bf16_t*)(ws + WS_R + (size_t)(MK_DUMP - 2) * SZ_ROW1K))[i]);
            p.out[i] = v;
        }
    }
#undef IN
#undef BOTH
}

extern "C" void kernel_launch(void* const* d_in, const int* in_sizes, int n_in, void* d_out, int out_size, void* d_ws, size_t ws_size, hipStream_t stream) {
    static int grid = 0;
    if (grid == 0) {
        if (n_in != 19 || ws_size < WS_TOTAL) { fprintf(stderr, "kernel_launch: expected 19 inputs and >= %zu bytes of workspace; got %d, %zu\n", (size_t)WS_TOTAL, n_in, ws_size); grid = -1; return; }
        int dev = 0, cus = 0, per_cu = 0;
        hipGetDevice(&dev);
        hipDeviceGetAttribute(&cus, hipDeviceAttributeMultiprocessorCount, dev);
        if (hipFuncSetAttribute((const void*)yoco_fwd, hipFuncAttributeMaxDynamicSharedMemorySize, LDS_BYTES) != hipSuccess) { fprintf(stderr, "kernel_launch: hipFuncSetAttribute failed\n"); grid = -1; return; }
        if (hipOccupancyMaxActiveBlocksPerMultiprocessor(&per_cu, (const void*)yoco_fwd, 512, LDS_BYTES) != hipSuccess || per_cu < 1) { fprintf(stderr, "kernel_launch: occupancy query says %d\n", per_cu); per_cu = 1; }
        (void)hipGetLastError();
        grid = cus * 1;
    }
    if (grid < 0) return;
    if (hipMemsetAsync((char*)d_ws + WS_BAR, 0, 16384, stream) != hipSuccess) { fprintf(stderr, "kernel_launch: memset of the barrier words failed\n"); return; }
    Params p{};
    p.x = (const float*)d_in[0]; p.meta = (const float*)d_in[1]; p.g_norm_a = (const float*)d_in[2]; p.w_in_a = (const float*)d_in[3]; p.w_gate_up_a = (const float*)d_in[4];
    p.b_gate_a = (const float*)d_in[5]; p.g_onorm_a = (const float*)d_in[6]; p.w_out_a = (const float*)d_in[7]; p.g_kv_norm = (const float*)d_in[8]; p.w_kv = (const float*)d_in[9];
    p.g_k = (const float*)d_in[10]; p.g_norm_b = (const float*)d_in[11]; p.w_q_b = (const float*)d_in[12]; p.g_q_b = (const float*)d_in[13]; p.w_o_b = (const float*)d_in[14];
    p.g_ffn_norm = (const float*)d_in[15]; p.w_ffn_gate = (const float*)d_in[16]; p.w_ffn_up = (const float*)d_in[17]; p.w_ffn_down = (const float*)d_in[18];
    p.out = (float*)d_out; p.ws = (unsigned char*)d_ws;
#ifndef MK_SPLIT
#define MK_SPLIT 0
#endif
    constexpr int NPH = 18;
    if (MK_SPLIT) {
        for (int k0 = 0; k0 <= MK_STOP + (MK_STOP < 17 ? 1 : 0); ++k0) {
            const int k = k0 <= MK_STOP ? k0 : 18;
            p.ph_lo = k; p.ph_hi = k + 1;
            void* args[] = {&p};
            hipError_t e = hipLaunchCooperativeKernel((const void*)yoco_fwd, dim3(grid), dim3(512), args, LDS_BYTES, stream);
            if (e != hipSuccess) { fprintf(stderr, "kernel_launch: launch %d failed: %s (grid %d)\n", k, hipGetErrorString(e), grid); break; }
        }
    } else {
        p.ph_lo = 0; p.ph_hi = NPH;
        void* args[] = {&p};
        hipError_t e = hipLaunchCooperativeKernel((const void*)yoco_fwd, dim3(grid), dim3(512), args, LDS_BYTES, stream);
        if (e != hipSuccess) fprintf(stderr, "kernel_launch: cooperative launch failed: %s (grid %d)\n", hipGetErrorString(e), grid);
    }
}
```

```cpp
#include <hip/hip_runtime.h>
#include <hip/hip_cooperative_groups.h>
#include <cstdio>
#include <cstdint>
namespace cg = cooperative_groups;

#define LAS __attribute__((address_space(3)))
typedef unsigned short bf16_t;
typedef short bf16x8 __attribute__((ext_vector_type(8)));
typedef float f32x4 __attribute__((ext_vector_type(4)));
typedef float f32x16 __attribute__((ext_vector_type(16)));
typedef unsigned u32x4 __attribute__((ext_vector_type(4)));
typedef unsigned u32x2 __attribute__((ext_vector_type(2)));

constexpr int BATCH = 2, SEQ = 4096, LTOT = 4224, DM = 2048, MTOT = BATCH * LTOT;
constexpr int PADN = 112, OFFS = 128;
constexpr int DFF = 5632, NIN = 6160;
constexpr int GKD = 1024;
constexpr float EPS = 1e-6f;

constexpr size_t SZ_WIN = (size_t)6144 * 2048 * 2, SZ_SQ = (size_t)2048 * 2048 * 2, SZ_WF = (size_t)11264 * 2048 * 2, SZ_WD = (size_t)2048 * 5632 * 2;
constexpr size_t WS_WIN = 0, WS_WOUTA = WS_WIN + SZ_WIN, WS_WF0 = WS_WOUTA + SZ_SQ, WS_WD0 = WS_WF0 + SZ_WF;
constexpr size_t WS_WKVQ = WS_WD0 + SZ_WD, WS_WOB = WS_WKVQ + SZ_WIN, WS_WF1 = WS_WOB + SZ_SQ, WS_WD1 = WS_WF1 + SZ_WF;
constexpr size_t WS_XN = WS_WD1 + SZ_WD;
constexpr size_t SZ_ROW2K = (size_t)MTOT * 2048 * 2, SZ_ROW1K = (size_t)MTOT * 1024 * 2;
constexpr size_t WS_R = WS_XN + SZ_ROW2K;
constexpr size_t WS_QA = WS_R, WS_KA = WS_QA + SZ_ROW1K, WS_VTA = WS_KA + SZ_ROW1K, WS_GA = WS_VTA + SZ_ROW2K, WS_KST = WS_GA + SZ_ROW2K;
constexpr size_t WS_REND = WS_KST + SZ_ROW1K;
constexpr size_t WS_ACT = WS_R;
constexpr size_t WS_KR = WS_R, WS_QR = WS_KR + SZ_ROW2K, WS_VTB = WS_QR + SZ_ROW2K;
static_assert(WS_ACT + (size_t)MTOT * DFF * 2 <= WS_REND && WS_VTB + SZ_ROW2K <= WS_REND, "region");
constexpr size_t WS_HO = WS_REND;
constexpr size_t WS_AG = WS_HO + (size_t)MTOT * 2048 * 4;
constexpr size_t WS_DC = WS_AG + (size_t)MTOT * 16 * 4;
constexpr size_t WS_SSQ = WS_DC + (size_t)528 * 256 * 4;
constexpr size_t WS_SLAB = WS_SSQ + (size_t)MTOT * 32 * 4;
constexpr size_t WS_END = WS_SLAB + (size_t)11 * 256 * 2048 * 4;
constexpr size_t WS_BAR = WS_END;
constexpr size_t WS_TOTAL = WS_BAR + 16384;
constexpr size_t WS_OG = WS_QA;
constexpr size_t WS_OB = WS_WIN;
static_assert(WS_OB + SZ_ROW2K <= WS_WD0, "OB overlays layer-A weights only");

constexpr int LDS_BYTES = 155648;

typedef __bf16 bf16x2_t __attribute__((ext_vector_type(2)));
typedef float f32x2_t __attribute__((ext_vector_type(2)));
__device__ __forceinline__ unsigned cvt_pk_bf16_v(float lo, float hi) { const f32x2_t v = {lo, hi}; const bf16x2_t b = __builtin_convertvector(v, bf16x2_t); return __builtin_bit_cast(unsigned, b); }
__device__ __forceinline__ unsigned cvt_pk_bf16(float lo, float hi) { unsigned r; asm("v_cvt_pk_bf16_f32 %0, %1, %2" : "=v"(r) : "v"(lo), "v"(hi)); return r; }
__device__ __forceinline__ float bf_lo(unsigned u) { return __builtin_bit_cast(float, u << 16); }
__device__ __forceinline__ float bf_hi(unsigned u) { return __builtin_bit_cast(float, u & 0xffff0000u); }
__device__ __forceinline__ float wave_sum(float v) {
#pragma unroll
    for (int o = 1; o < 64; o <<= 1) v += __shfl_xor(v, o);
    return v;
}
__device__ __forceinline__ int opaque_tid() { int t = threadIdx.x; asm volatile("" : "+v"(t)); return t; }
__device__ __forceinline__ unsigned char* opaque_ptr(unsigned char* q) { asm volatile("" : "+s"(q)); return q; }
__device__ __forceinline__ float silu_f(float x) { return x * __builtin_amdgcn_rcpf(1.f + __expf(-x)); }
__device__ __forceinline__ float log2_sigmoid2_f(float x) { return fminf(x, 0.f) - __builtin_amdgcn_logf(1.f + __builtin_amdgcn_exp2f(-fabsf(x))); }
__device__ __forceinline__ float log_sigmoid_f(float x) { return fminf(x, 0.f) - 0.6931471805599453f * __builtin_amdgcn_logf(1.f + __expf(-fabsf(x))); }

#define XB_TMO      128
#define XB_XCNT(j)  (256  + 64 * (j))
#define XB_XSUB(j)  (1280 + 64 * (j))
#define XB_XGEN(j)  (2304 + 64 * (j))
#define XB_TOP      3328
#define XB_TOPGEN   3392
#define XCD_BAR_WORDS 3456
#define XB_SPIN_CAP (1u << 20)
__device__ __forceinline__ unsigned xb_ld(unsigned* p)              { return __hip_atomic_load(p, __ATOMIC_RELAXED, __HIP_MEMORY_SCOPE_AGENT); }
__device__ __forceinline__ unsigned xb_add(unsigned* p, unsigned v) { return __hip_atomic_fetch_add(p, v, __ATOMIC_RELAXED, __HIP_MEMORY_SCOPE_AGENT); }
__device__ __forceinline__ unsigned xb_xcc_id() { return (unsigned)__builtin_amdgcn_s_getreg((3 << 11) | 20) & 0xFu; }
#define XB_SPIN(cond, bar) do { unsigned _sp = 0; while (cond) { __builtin_amdgcn_s_sleep(1); \
    if ((++_sp & 255u) == 0u) { if (xb_ld(&(bar)[XB_TMO])) break; if (_sp > XB_SPIN_CAP) { atomicAdd(&(bar)[XB_TMO], 1u); break; } } } } while (0)
struct XcdBarrier { unsigned* bar; unsigned x; volatile LAS unsigned* st; };
__device__ __forceinline__ XcdBarrier xcd_barrier_post(unsigned* bar, volatile LAS unsigned* st) {
    XcdBarrier b; b.bar = bar; b.x = xb_xcc_id(); b.st = st;
    if (threadIdx.x == 0) (void)xb_add(&bar[XB_XCNT(b.x)], 1u);
    return b;
}
__device__ __forceinline__ void xcd_barrier_complete(unsigned* bar, unsigned x, unsigned& nloc, unsigned& nx) {
    const unsigned G = gridDim.x * gridDim.y * gridDim.z;
    unsigned sum, cnt, mine, sp = 0u;
    for (;;) {
        sum = 0u; cnt = 0u; mine = 0u;
#pragma unroll
        for (unsigned j = 0; j < 16; ++j) { const unsigned c = xb_ld(&bar[XB_XCNT(j)]); sum += c; cnt += (c > 0u) ? 1u : 0u; mine = (j == x) ? c : mine; }
        if (sum == G) break;
        __builtin_amdgcn_s_sleep(1);
        if ((++sp & 255u) == 0u) { if (xb_ld(&bar[XB_TMO])) break; if (sp > XB_SPIN_CAP) { atomicAdd(&bar[XB_TMO], 1u); break; } }
    }
    nloc = mine > 0u ? mine : 1u; nx = cnt > 0u ? cnt : 1u;
}
__device__ __forceinline__ void xcd_barrier(const XcdBarrier& b) {
    asm volatile("s_waitcnt vmcnt(0)" ::: "memory");
    __syncthreads();
    if (threadIdx.x == 0) {
        unsigned* bar = b.bar;
        __builtin_amdgcn_s_waitcnt(0);
        unsigned nloc = b.st[0], nx = b.st[1];
        if (nloc == 0u) { xcd_barrier_complete(bar, b.x, nloc, nx); b.st[0] = nloc; b.st[1] = nx; }
        const unsigned old = xb_add(&bar[XB_XSUB(b.x)], 1u);
        const unsigned gen = old / nloc;
        if (old + 1u == (gen + 1u) * nloc) {
            __builtin_amdgcn_fence(__ATOMIC_RELEASE, "agent");
            asm volatile("s_waitcnt vmcnt(0)" ::: "memory");
            const unsigned og = xb_add(&bar[XB_TOP], 1u);
            const unsigned tg = og / nx;
            if (og + 1u == (tg + 1u) * nx) xb_add(&bar[XB_TOPGEN], 1u);
            else XB_SPIN(xb_ld(&bar[XB_TOPGEN]) == tg, bar);
            __builtin_amdgcn_fence(__ATOMIC_ACQUIRE, "agent");
            xb_add(&bar[XB_XGEN(b.x)], 1u);
            asm volatile("s_waitcnt vmcnt(0)" ::: "memory");
        } else {
            XB_SPIN(xb_ld(&bar[XB_XGEN(b.x)]) == gen, bar);
            __builtin_amdgcn_fence(__ATOMIC_ACQUIRE, "agent");
            asm volatile("s_waitcnt vmcnt(0)" ::: "memory");
        }
    }
    __syncthreads();
}


namespace pg8 {
constexpr int BM = 256, BK = 64, HALF = 128, HTB = HALF * BK * 2, NXCD = 8, WGM = 8;
__host__ __device__ __forceinline__ int lds_byte(int r, int c) { const int st = (r >> 4) * 2 + (c >> 5), rr = r & 15, cc = c & 31, ob = rr * 64 + cc * 2; return st * 1024 + (ob ^ (((ob >> 9) & 1) << 5)); }
__host__ __device__ __forceinline__ void stage_rc(int b, int& R, int& C) { const int st = b / 1024, sb = b % 1024, swz = sb ^ (((sb >> 9) & 1) << 5); R = (st >> 1) * 16 + swz / 64; C = (st & 1) * 32 + (swz % 64) / 2; }
__host__ __device__ __forceinline__ int perm32(int rho) { const int n = rho >> 4, i = rho & 15; return 8 * (i >> 2) + 4 * n + (i & 3); }
struct Unit { int pm, pn, kb, nt, split; };
struct Gemm { const bf16_t* A; const bf16_t* Bt; int M, N, K; };
struct StaticOrder {
    int nM, nN, nwg, G, c, ntf;
    __host__ __device__ void init(int M, int N, int K, int G_, int c_) { nM = M / BM; nN = N / BM; nwg = nM * nN; G = G_; c = c_; ntf = K / BK; }
    __host__ __device__ void map(long L, Unit& u) const {
        int wgid = (int)L; { const int q = nwg / NXCD, r = nwg % NXCD, xcd = wgid % NXCD, off = wgid / NXCD; wgid = (xcd < r ? xcd * (q + 1) : r * (q + 1) + (xcd - r) * q) + off; }
        const int nig = WGM * nN, gid = wgid / nig, fm = gid * WGM, gsz = (nM - fm) < WGM ? (nM - fm) : WGM;
        u.pm = fm + ((wgid % nig) % gsz); u.pn = (wgid % nig) / gsz; u.kb = 0; u.nt = ntf; u.split = 0;
    }
    __host__ __device__ bool next(int i, Unit& u) const { const long L = (long)i * G + c; if (L >= nwg) return false; map(L, u); return true; }
    __device__ __forceinline__ void a_ready(const Unit&) const {}
    __device__ __forceinline__ void done(const Unit&) const {}
};
struct TailOrder {
    StaticOrder so; int ntu, nun;
    __host__ __device__ void init(int N, int K, int G_, int c_, int nsplit) { so.init(8192, N, K, G_, c_); ntu = (K / BK) / nsplit; nun = so.nN * nsplit; }
    __host__ __device__ bool next(int i, Unit& u) const {
        const long L = (long)i * so.G + so.c;
        if (L < so.nwg) { so.map(L, u); return true; }
        const long j = L - so.nwg; if (j >= nun) return false;
        u.pm = so.nM; u.pn = (int)(j % so.nN); const int sidx = (int)(j / so.nN); u.kb = sidx * ntu * (BK * 2); u.nt = ntu; u.split = 1 + sidx; return true;
    }
    __device__ __forceinline__ void a_ready(const Unit&) const {}
    __device__ __forceinline__ void done(const Unit&) const {}
};
template <class Epi, class Sched, bool ALIGN_EPI = false, bool SP2 = false>
__device__ __forceinline__ void gemm_phase(LAS unsigned char* lds, const Gemm g, const Sched& S, const Epi& E) {
    const int tid = opaque_tid(), wid = __builtin_amdgcn_readfirstlane(tid >> 6), lane = tid & 63, wr = wid >> 2, wc = wid & 3, fr = lane & 15, fq = lane >> 4;
    const int K = g.K;
    unsigned voffA[2], voffB[2];
#pragma unroll
    for (int i = 0; i < 2; ++i) { int R, C; stage_rc(tid * 16 + i * 8192, R, C); const int Rb = Epi::PERM ? ((R & ~31) + perm32(R & 31)) : R;
        voffA[i] = (unsigned)(R * K + C) * 2u; voffB[i] = (unsigned)(Rb * K + C) * 2u; }
    const size_t kstep = (size_t)(BK * 2);
    const size_t hstep = (size_t)HALF * K * 2;
    const size_t tstep = 2 * hstep;
    const unsigned ldsw = (unsigned)wid * 1024u;
    const int aoff = lds_byte(wr * 64 + fr, fq * 8), boff = lds_byte(wc * 32 + fr, fq * 8);
#define PG8_SA(b, h) (((b) * 2 + (h)) * HTB)
#define PG8_SB(b, h) ((4 + (b) * 2 + (h)) * HTB)
#define PG8_STAGE(bufoff, gbase, voff) do { _Pragma("unroll") for (int _i = 0; _i < 2; ++_i) \
        __builtin_amdgcn_global_load_lds((const unsigned*)((const char*)(gbase) + (voff)[_i]), (LAS unsigned*)(lds + (bufoff) + ldsw + _i * 8192), 16, 0, 0); } while (0)
#define PG8_LDA(dst, b, h) do { _Pragma("unroll") for (int m = 0; m < 4; ++m) _Pragma("unroll") for (int k = 0; k < 2; ++k) dst[m][k] = *(const LAS bf16x8*)(lds + PG8_SA(b, h) + aoff + m * 2048 + k * 1024); } while (0)
#define PG8_LDB(dst, b, h) do { _Pragma("unroll") for (int n = 0; n < 2; ++n) _Pragma("unroll") for (int k = 0; k < 2; ++k) dst[n][k] = *(const LAS bf16x8*)(lds + PG8_SB(b, h) + boff + n * 2048 + k * 1024); } while (0)
#define PG8_MMA(ai, bj, At, Bt) do { __builtin_amdgcn_s_setprio(1); _Pragma("unroll") for (int m = 0; m < 4; ++m) _Pragma("unroll") for (int n = 0; n < 2; ++n) _Pragma("unroll") for (int k = 0; k < 2; ++k) \
        acc[ai][bj][m][n] = __builtin_amdgcn_mfma_f32_16x16x32_bf16(Bt[n][k], At[m][k], acc[ai][bj][m][n], 0, 0, 0); __builtin_amdgcn_s_setprio(0); } while (0)
#define PG8_WAIT_V(n) asm volatile("s_waitcnt vmcnt(" #n ")" ::: "memory")
#define PG8_WAIT_L(n) asm volatile("s_waitcnt lgkmcnt(" #n ")" ::: "memory")
#define PG8_BAR __builtin_amdgcn_s_barrier()
#define PG8_SCHED __builtin_amdgcn_sched_barrier(0)
    Unit cur, nxt; int ui = 0;
    if (!S.next(0, cur)) return;
    f32x4 acc[2][2][4][2];
#pragma unroll
    for (int a = 0; a < 2; ++a)
#pragma unroll
        for (int b = 0; b < 2; ++b)
#pragma unroll
            for (int m = 0; m < 4; ++m)
#pragma unroll
                for (int n = 0; n < 2; ++n) acc[a][b][m][n] = (f32x4){0.f, 0.f, 0.f, 0.f};
    bf16x8 At[4][2], B0[2][2], B1[2][2];
    const char* cA = (const char*)g.A + (size_t)cur.pm * tstep + cur.kb; const char* cB = (const char*)g.Bt + (size_t)cur.pn * tstep + cur.kb;
    S.a_ready(cur);
    if constexpr (SP2) {
        PG8_STAGE(PG8_SB(0, 0), cB, voffB); PG8_STAGE(PG8_SB(0, 1), cB + hstep, voffB); PG8_STAGE(PG8_SA(0, 0), cA, voffA); PG8_STAGE(PG8_SA(0, 1), cA + hstep, voffA);
        if (wr == 1) PG8_BAR;
        PG8_WAIT_V(2); PG8_BAR;
        PG8_STAGE(PG8_SB(1, 0), cB + kstep, voffB); PG8_STAGE(PG8_SA(1, 0), cA + kstep, voffA); PG8_STAGE(PG8_SB(1, 1), cB + hstep + kstep, voffB);
        PG8_WAIT_V(6); PG8_BAR;
    } else {
        PG8_STAGE(PG8_SB(0, 0), cB, voffB); PG8_STAGE(PG8_SA(0, 0), cA, voffA); PG8_STAGE(PG8_SB(0, 1), cB + hstep, voffB); PG8_STAGE(PG8_SA(0, 1), cA + hstep, voffA);
        if (wr == 1) PG8_BAR;
        PG8_WAIT_V(4); PG8_BAR;
        PG8_STAGE(PG8_SB(1, 0), cB + kstep, voffB); PG8_STAGE(PG8_SA(1, 0), cA + kstep, voffA); PG8_STAGE(PG8_SB(1, 1), cB + hstep + kstep, voffB);
        PG8_WAIT_V(6); PG8_BAR;
    }
    for (;;) {
        const bool has_next = S.next(ui + 1, nxt);
        const char* nA = has_next ? (const char*)g.A + (size_t)nxt.pm * tstep + nxt.kb : cA; const char* nB = has_next ? (const char*)g.Bt + (size_t)nxt.pn * tstep + nxt.kb : cB;
        const int nt = cur.nt;
        for (int t = 0; t < nt; t += 2) {
            const bool last = (t == nt - 2);
            const char* a1 = cA + (size_t)(t + 1) * kstep;
            const char* a2 = last ? nA : cA + (size_t)(t + 2) * kstep; const char* b2 = last ? nB : cB + (size_t)(t + 2) * kstep;
            const char* a3 = a2 + kstep; const char* b3 = b2 + kstep;
            if (last && has_next) S.a_ready(nxt);
            if constexpr (SP2) {
            PG8_LDB(B0, 0, 0); PG8_LDB(B1, 0, 1); PG8_SCHED; PG8_LDA(At, 0, 0); PG8_STAGE(PG8_SA(1, 1), a1 + hstep, voffA);
            PG8_WAIT_V(8); PG8_WAIT_L(0); PG8_BAR; PG8_MMA(0, 0, At, B0); PG8_MMA(0, 1, At, B1); PG8_BAR; PG8_SCHED;
            PG8_LDA(At, 0, 1); PG8_STAGE(PG8_SB(0, 0), b2, voffB); PG8_STAGE(PG8_SB(0, 1), b2 + hstep, voffB); PG8_STAGE(PG8_SA(0, 0), a2, voffA);
            PG8_WAIT_V(8); PG8_WAIT_L(0); PG8_BAR; PG8_MMA(1, 0, At, B0); PG8_MMA(1, 1, At, B1); PG8_BAR; PG8_SCHED;
            PG8_LDB(B0, 1, 0); PG8_LDB(B1, 1, 1); PG8_SCHED; PG8_LDA(At, 1, 0); PG8_STAGE(PG8_SA(0, 1), a2 + hstep, voffA);
            PG8_WAIT_V(8); PG8_WAIT_L(0); PG8_BAR; PG8_MMA(0, 0, At, B0); PG8_MMA(0, 1, At, B1); PG8_BAR; PG8_SCHED;
            PG8_LDA(At, 1, 1); PG8_STAGE(PG8_SB(1, 0), b3, voffB); PG8_STAGE(PG8_SB(1, 1), b3 + hstep, voffB); PG8_STAGE(PG8_SA(1, 0), a3, voffA);
            PG8_WAIT_V(8); PG8_WAIT_L(0); PG8_BAR; PG8_MMA(1, 0, At, B0); PG8_MMA(1, 1, At, B1); PG8_BAR; PG8_SCHED;
            } else {
            PG8_LDB(B0, 0, 0); PG8_SCHED; PG8_LDA(At, 0, 0); PG8_STAGE(PG8_SA(1, 1), a1 + hstep, voffA);
            PG8_WAIT_L(8); PG8_BAR; PG8_WAIT_L(0); PG8_MMA(0, 0, At, B0); PG8_BAR; PG8_SCHED;
            PG8_LDB(B1, 0, 1); PG8_STAGE(PG8_SB(0, 0), b2, voffB);
            PG8_BAR; PG8_WAIT_L(0); PG8_MMA(0, 1, At, B1); PG8_BAR;
            PG8_LDA(At, 0, 1); PG8_STAGE(PG8_SA(0, 0), a2, voffA);
            PG8_BAR; PG8_WAIT_L(0); PG8_MMA(1, 0, At, B0); PG8_BAR; PG8_SCHED;
            PG8_STAGE(PG8_SB(0, 1), b2 + hstep, voffB);
            PG8_WAIT_V(6); PG8_BAR; PG8_MMA(1, 1, At, B1); PG8_BAR;
            PG8_LDB(B0, 1, 0); PG8_SCHED; PG8_LDA(At, 1, 0); PG8_STAGE(PG8_SA(0, 1), a2 + hstep, voffA);
            PG8_WAIT_L(8); PG8_BAR; PG8_WAIT_L(0); PG8_MMA(0, 0, At, B0); PG8_BAR; PG8_SCHED;
            PG8_LDB(B1, 1, 1); PG8_STAGE(PG8_SB(1, 0), b3, voffB);
            PG8_BAR; PG8_WAIT_L(0); PG8_MMA(0, 1, At, B1); PG8_BAR;
            PG8_LDA(At, 1, 1); PG8_STAGE(PG8_SA(1, 0), a3, voffA);
            PG8_BAR; PG8_WAIT_L(0); PG8_MMA(1, 0, At, B0); PG8_BAR; PG8_SCHED;
            PG8_STAGE(PG8_SB(1, 1), b3 + hstep, voffB);
            PG8_WAIT_V(6); PG8_BAR; PG8_MMA(1, 1, At, B1); PG8_BAR;
            }
        }
        if constexpr (ALIGN_EPI) { if (wr == 0) PG8_BAR; }
        if constexpr (!Epi::AFTER_DRAIN) { E(acc, cur, wr, wc, fr, fq); S.done(cur); }
        if (!has_next) break;
#pragma unroll
        for (int a = 0; a < 2; ++a)
#pragma unroll
            for (int b = 0; b < 2; ++b)
#pragma unroll
                for (int m = 0; m < 4; ++m)
#pragma unroll
                    for (int n = 0; n < 2; ++n) acc[a][b][m][n] = (f32x4){0.f, 0.f, 0.f, 0.f};
        cur = nxt; cA = nA; cB = nB; ++ui;
        if constexpr (ALIGN_EPI) { if (wr == 1) PG8_BAR; }
    }
    PG8_WAIT_V(0);
    if constexpr (!ALIGN_EPI) { if (wr == 0) PG8_BAR; }
    PG8_BAR;
#undef PG8_SA
#undef PG8_SB
#undef PG8_STAGE
#undef PG8_LDA
#undef PG8_LDB
#undef PG8_MMA
#undef PG8_WAIT_V
#undef PG8_WAIT_L
#undef PG8_BAR
#undef PG8_SCHED
}
}

struct Params {
    const float *x, *meta, *g_norm_a, *w_in_a, *w_gate_up_a, *b_gate_a, *g_onorm_a, *w_out_a, *g_kv_norm, *w_kv, *g_k, *g_norm_b, *w_q_b, *g_q_b, *w_o_b,
        *g_ffn_norm, *w_ffn_gate, *w_ffn_up, *w_ffn_down;
    float* out;
    unsigned char* ws;
    int ph_lo, ph_hi;
};

__device__ __forceinline__ const float* h0_row(const Params& p, int r) {
    const int b = r >= LTOT ? 1 : 0, pos = r - b * LTOT;
    if (pos < PADN) return nullptr;
    if (pos < OFFS) return p.meta + (size_t)(pos - PADN) * DM;
    return p.x + ((size_t)b * SEQ + (pos - OFFS)) * DM;
}

struct EpiIn {
    static constexpr bool PERM = true, AFTER_DRAIN = false;
    bf16_t *QA, *KA, *VTA, *GA; float one;
    __device__ __forceinline__ void operator()(const f32x4 (&acc)[2][2][4][2], const pg8::Unit& u, int wr, int wc, int fr, int fq) const {
        const int pn = u.pn;
#pragma unroll
        for (int ai = 0; ai < 2; ++ai)
#pragma unroll
            for (int m = 0; m < 4; ++m) {
                const int r = u.pm * 256 + ai * 128 + wr * 64 + m * 16 + fr;
#pragma unroll
                for (int bj = 0; bj < 2; ++bj) {
                    const int c = pn * 256 + bj * 128 + wc * 32 + fq * 8;
                    const f32x4 v0 = acc[ai][bj][m][0] * one, v1 = acc[ai][bj][m][1] * one;
                    if (pn < 4) {
                        const float sc = 0.0625f;
                        u32x4 w = {cvt_pk_bf16(v0[0] * sc, v0[1] * sc), cvt_pk_bf16(v0[2] * sc, v0[3] * sc), cvt_pk_bf16(v1[0] * sc, v1[1] * sc), cvt_pk_bf16(v1[2] * sc, v1[3] * sc)};
                        *(u32x4*)(QA + (size_t)r * GKD + c) = w;
                    } else if (pn < 8) {
                        u32x4 w = {cvt_pk_bf16(v0[0], v0[1]), cvt_pk_bf16(v0[2], v0[3]), cvt_pk_bf16(v1[0], v1[1]), cvt_pk_bf16(v1[2], v1[3])};
                        *(u32x4*)(KA + (size_t)r * GKD + (c - 1024)) = w;
                    } else if (pn < 16) {
                        const int cv = c - 2048, hh = cv >> 9, dv = cv & 511;
                        const int b = r >= LTOT ? 1 : 0, pos = r - b * LTOT;
                        bf16_t* dst = VTA + ((size_t)((b * 4 + hh) * 512 + dv)) * LTOT + pos;
                        const unsigned w0 = cvt_pk_bf16(v0[0], v0[1]), w1 = cvt_pk_bf16(v0[2], v0[3]), w2 = cvt_pk_bf16(v1[0], v1[1]), w3 = cvt_pk_bf16(v1[2], v1[3]);
                        dst[0] = (bf16_t)w0; dst[(size_t)LTOT] = (bf16_t)(w0 >> 16); dst[(size_t)2 * LTOT] = (bf16_t)w1; dst[(size_t)3 * LTOT] = (bf16_t)(w1 >> 16);
                        dst[(size_t)4 * LTOT] = (bf16_t)w2; dst[(size_t)5 * LTOT] = (bf16_t)(w2 >> 16); dst[(size_t)6 * LTOT] = (bf16_t)w3; dst[(size_t)7 * LTOT] = (bf16_t)(w3 >> 16);
                    } else {
                        u32x4 w = {cvt_pk_bf16(silu_f(v0[0]), silu_f(v0[1])), cvt_pk_bf16(silu_f(v0[2]), silu_f(v0[3])), cvt_pk_bf16(silu_f(v1[0]), silu_f(v1[1])), cvt_pk_bf16(silu_f(v1[2]), silu_f(v1[3]))};
                        *(u32x4*)(GA + (size_t)r * DM + (c - 4096)) = w;
                    }
                }
            }
    }
};
struct EpiKvq {
    static constexpr bool PERM = true, AFTER_DRAIN = false;
    bf16_t *KR, *VTB, *QR; const float* SSQ;
    __device__ __forceinline__ void operator()(const f32x4 (&acc)[2][2][4][2], const pg8::Unit& u, int wr, int wc, int fr, int fq) const {
        const int pn = u.pn;
#pragma unroll
        for (int ai = 0; ai < 2; ++ai)
#pragma unroll
            for (int m = 0; m < 4; ++m) {
                const int r = u.pm * 256 + ai * 128 + wr * 64 + m * 16 + fr;
                float rsv;
                { const f32x4 a = *(const f32x4*)(SSQ + (size_t)r * 32 + fq * 8), b = *(const f32x4*)(SSQ + (size_t)r * 32 + fq * 8 + 4);
                  float t = ((a[0] + a[1]) + (a[2] + a[3])) + ((b[0] + b[1]) + (b[2] + b[3]));
                  t += __shfl_xor(t, 16); t += __shfl_xor(t, 32);
                  rsv = rsqrtf(t * (1.f / DM) + EPS); }
#pragma unroll
                for (int bj = 0; bj < 2; ++bj) {
                    const int c = pn * 256 + bj * 128 + wc * 32 + fq * 8;
                    const f32x4 v0 = acc[ai][bj][m][0] * rsv, v1 = acc[ai][bj][m][1] * rsv;
                    const unsigned w0 = cvt_pk_bf16(v0[0], v0[1]), w1 = cvt_pk_bf16(v0[2], v0[3]), w2 = cvt_pk_bf16(v1[0], v1[1]), w3 = cvt_pk_bf16(v1[2], v1[3]);
                    if (pn < 8) {
                        u32x4 w = {w0, w1, w2, w3};
                        *(u32x4*)(KR + (size_t)r * DM + c) = w;
                    } else if (pn < 16) {
                        const int cv = c - 2048, hh = cv >> 7, dv = cv & 127;
                        const int b = r >= LTOT ? 1 : 0, pos = r - b * LTOT;
                        bf16_t* dst = VTB + ((size_t)((b * 16 + hh) * 128 + dv)) * LTOT + pos;
                        dst[0] = (bf16_t)w0; dst[(size_t)LTOT] = (bf16_t)(w0 >> 16); dst[(size_t)2 * LTOT] = (bf16_t)w1; dst[(size_t)3 * LTOT] = (bf16_t)(w1 >> 16);
                        dst[(size_t)4 * LTOT] = (bf16_t)w2; dst[(size_t)5 * LTOT] = (bf16_t)(w2 >> 16); dst[(size_t)6 * LTOT] = (bf16_t)w3; dst[(size_t)7 * LTOT] = (bf16_t)(w3 >> 16);
                    } else {
                        u32x4 w = {w0, w1, w2, w3};
                        *(u32x4*)(QR + (size_t)r * DM + (c - 4096)) = w;
                    }
                }
            }
    }
};
struct EpiSwiglu {
    static constexpr bool PERM = true, AFTER_DRAIN = false;
    bf16_t* ACT; const float* SSQ;
    __device__ __forceinline__ void operator()(const f32x4 (&acc)[2][2][4][2], const pg8::Unit& u, int wr, int wc, int fr, int fq) const {
#pragma unroll
        for (int ai = 0; ai < 2; ++ai)
#pragma unroll
            for (int m = 0; m < 4; ++m) {
                const int r = u.pm * 256 + ai * 128 + wr * 64 + m * 16 + fr;
                float rsv;
                { const f32x4 a = *(const f32x4*)(SSQ + (size_t)r * 32 + fq * 8), b = *(const f32x4*)(SSQ + (size_t)r * 32 + fq * 8 + 4);
                  float t = ((a[0] + a[1]) + (a[2] + a[3])) + ((b[0] + b[1]) + (b[2] + b[3]));
                  t += __shfl_xor(t, 16); t += __shfl_xor(t, 32);
                  rsv = rsqrtf(t * (1.f / DM) + EPS); }
                const int c = u.pn * 128 + wc * 32 + fq * 8;
                const f32x4 g0 = acc[ai][0][m][0] * rsv, g1 = acc[ai][0][m][1] * rsv, u0 = acc[ai][1][m][0] * rsv, u1 = acc[ai][1][m][1] * rsv;
                u32x4 w = {cvt_pk_bf16(silu_f(g0[0]) * u0[0], silu_f(g0[1]) * u0[1]), cvt_pk_bf16(silu_f(g0[2]) * u0[2], silu_f(g0[3]) * u0[3]),
                           cvt_pk_bf16(silu_f(g1[0]) * u1[0], silu_f(g1[1]) * u1[1]), cvt_pk_bf16(silu_f(g1[2]) * u1[2], silu_f(g1[3]) * u1[3])};
                *(u32x4*)(ACT + (size_t)r * DFF + c) = w;
            }
    }
};
template <bool SRC0, bool FINAL, bool WXN>
struct EpiRes {
    static constexpr bool PERM = true, AFTER_DRAIN = false;
    const float *x, *meta; float *out, *HO; bf16_t* XN; float *SSQ, *SLAB;
    __device__ __forceinline__ void operator()(const f32x4 (&acc)[2][2][4][2], const pg8::Unit& u, int wr, int wc, int fr, int fq) const {
        if (u.split) {
            char* slab = (char*)SLAB + (size_t)(u.split - 1) * 256 * DM * 4;
#pragma unroll
            for (int ai = 0; ai < 2; ++ai)
#pragma unroll
                for (int m = 0; m < 4; ++m) {
                    const int rl = ai * 128 + wr * 64 + m * 16 + fr;
#pragma unroll
                    for (int bj = 0; bj < 2; ++bj) {
                        const unsigned bo = ((unsigned)rl * DM + (unsigned)(u.pn * 256 + bj * 128 + wc * 32 + fq * 8)) * 4u;
                        *(f32x4*)(slab + bo) = acc[ai][bj][m][0]; *(f32x4*)(slab + bo + 16) = acc[ai][bj][m][1];
                    }
                }
            return;
        }
#pragma unroll
        for (int ai = 0; ai < 2; ++ai)
#pragma unroll
            for (int m = 0; m < 4; ++m) {
                const int r = u.pm * 256 + ai * 128 + wr * 64 + m * 16 + fr;
                const int b = r >= LTOT ? 1 : 0, pos = r - b * LTOT;
                const unsigned c0 = (unsigned)(u.pn * 256 + wc * 32 + fq * 8);
                const unsigned eh = (unsigned)r * DM + c0;
                const unsigned eo = ((unsigned)(b * SEQ + (pos - OFFS))) * DM + c0;
                float ss = 0.f;
#pragma unroll
                for (int bj = 0; bj < 2; ++bj) {
                    f32x4 r0 = {0.f, 0.f, 0.f, 0.f}, r1 = {0.f, 0.f, 0.f, 0.f};
                    if (SRC0) {
                        if (pos >= OFFS) { r0 = *(const f32x4*)((const char*)x + (eo + bj * 128) * 4u); r1 = *(const f32x4*)((const char*)x + (eo + bj * 128) * 4u + 16); }
                        else if (pos >= PADN) { const unsigned em = ((unsigned)(pos - PADN) * DM + c0 + bj * 128) * 4u; r0 = *(const f32x4*)((const char*)meta + em); r1 = *(const f32x4*)((const char*)meta + em + 16); }
                    } else { r0 = *(const f32x4*)((const char*)HO + (eh + bj * 128) * 4u); r1 = *(const f32x4*)((const char*)HO + (eh + bj * 128) * 4u + 16); }
                    r0 += acc[ai][bj][m][0]; r1 += acc[ai][bj][m][1];
                    if (FINAL) { if (pos >= OFFS) { *(f32x4*)((char*)out + (eo + bj * 128) * 4u) = r0; *(f32x4*)((char*)out + (eo + bj * 128) * 4u + 16) = r1; } }
                    else { *(f32x4*)((char*)HO + (eh + bj * 128) * 4u) = r0; *(f32x4*)((char*)HO + (eh + bj * 128) * 4u + 16) = r1; }
                    if (WXN) {
                        ss += ((r0[0] * r0[0] + r0[1] * r0[1]) + (r0[2] * r0[2] + r0[3] * r0[3])) + ((r1[0] * r1[0] + r1[1] * r1[1]) + (r1[2] * r1[2] + r1[3] * r1[3]));
                        const u32x4 w = {cvt_pk_bf16(r0[0], r0[1]), cvt_pk_bf16(r0[2], r0[3]), cvt_pk_bf16(r1[0], r1[1]), cvt_pk_bf16(r1[2], r1[3])};
                        *(u32x4*)((char*)XN + (eh + bj * 128) * 2u) = w;
                    }
                }
                if (WXN) { ss += __shfl_xor(ss, 16); ss += __shfl_xor(ss, 32); if (fq == 0) *(float*)((char*)SSQ + ((unsigned)r * 32 + u.pn * 4 + wc) * 4u) = ss; }
            }
    }
};

template <bool SRC0, bool FINAL>
__device__ __forceinline__ void tail_fix_phase(const Params& p, int nsplit) {
    const int tid = opaque_tid(), lane = tid & 63, wave = tid >> 6;
    float* HO = (float*)(p.ws + WS_HO); bf16_t* XN = (bf16_t*)(p.ws + WS_XN); float* SSQ = (float*)(p.ws + WS_SSQ); const float* SLAB = (const float*)(p.ws + WS_SLAB);
    for (int rr = blockIdx.x; rr < 256; rr += gridDim.x) {
        const int r = 8192 + rr, cols = wave * 256 + lane * 4;
        const float* src = SRC0 ? h0_row(p, r) : HO + (size_t)r * DM;
        f32x4 v = src ? *(const f32x4*)(src + cols) : (f32x4){0.f, 0.f, 0.f, 0.f};
        for (int sidx = 0; sidx < nsplit; ++sidx) v += *(const f32x4*)(SLAB + ((size_t)sidx * 256 + rr) * DM + cols);
        if (FINAL) {
            const int pos = r - LTOT;
            *(f32x4*)(p.out + ((size_t)SEQ + (pos - OFFS)) * DM + cols) = v;
        } else {
            *(f32x4*)(HO + (size_t)r * DM + cols) = v;
            const u32x2 w = {cvt_pk_bf16(v[0], v[1]), cvt_pk_bf16(v[2], v[3])};
            *(u32x2*)(XN + (size_t)r * DM + cols) = w;
            const float ss = wave_sum((v[0] * v[0] + v[1] * v[1]) + (v[2] * v[2] + v[3] * v[3]));
            if (lane == 0) SSQ[(size_t)r * 32 + wave] = ss;
            if (wave == 0 && lane < 24) SSQ[(size_t)r * 32 + 8 + lane] = 0.f;
        }
    }
}

__device__ __forceinline__ void tr_region(LAS unsigned char* lds, const float* __restrict__ W, int pitch, int K, int ncols, const float* __restrict__ gain, bf16_t* dst, int mode, int row_off, int first, int stride) {
    const int tid = opaque_tid();
    const int nN = ncols >> 8, nK = K >> 6, ntl = nN * nK;
    LAS bf16_t* tile = (LAS bf16_t*)lds;
    const int n4 = tid & 63, kq = tid >> 6;
    f32x4 v[8], vn[8];
#define TR_LOAD(dstv, tt) do { const int _kt = (tt) / nN, _nt = (tt) - _kt * nN; \
        _Pragma("unroll") for (int i = 0; i < 8; ++i) dstv[i] = __builtin_nontemporal_load((const f32x4*)(W + (size_t)((_kt << 6) + kq * 8 + i) * pitch + (_nt << 8) + 4 * n4)); } while (0)
    int t = first;
    if (t < ntl) TR_LOAD(v, t);
    for (; t < ntl; t += stride) {
        const int kt = t / nN, ntile = t - kt * nN, k0 = kt << 6, n0 = ntile << 8;
        if (t + stride < ntl) TR_LOAD(vn, t + stride);
        if (gain) {
#pragma unroll
            for (int i = 0; i < 8; ++i) v[i] = v[i] * gain[k0 + kq * 8 + i];
        }
#pragma unroll
        for (int j = 0; j < 4; ++j) {
            const u32x4 o = {cvt_pk_bf16(v[0][j], v[1][j]), cvt_pk_bf16(v[2][j], v[3][j]), cvt_pk_bf16(v[4][j], v[5][j]), cvt_pk_bf16(v[6][j], v[7][j])};
            *(LAS u32x4*)(tile + (4 * n4 + j) * 72 + kq * 8) = o;
        }
        __syncthreads();
#pragma unroll
        for (int i = 0; i < 4; ++i) {
            const int q = tid + 512 * i, n = q >> 3, ch = q & 7;
            const u32x4 o = *(LAS u32x4*)(tile + n * 72 + ch * 8);
            const int nn = n0 + n;
            const int row = mode == 0 ? row_off + nn : ((nn >> 7) * 256 + (mode == 2 ? 128 : 0) + (nn & 127));
            *(u32x4*)(dst + (size_t)row * K + k0 + ch * 8) = o;
        }
        __syncthreads();
#pragma unroll
        for (int i = 0; i < 8; ++i) v[i] = vn[i];
    }
#undef TR_LOAD
}
__device__ __forceinline__ void tr_deferred(const Params& p, LAS unsigned char* lds, int first, int stride, int groups) {
    unsigned char* ws = p.ws;
    if (groups & 1) {
        tr_region(lds, p.w_out_a, 2048, 2048, 2048, nullptr, (bf16_t*)(ws + WS_WOUTA), 0, 0, first, stride);
        tr_region(lds, p.w_ffn_gate, DFF, 2048, DFF, p.g_ffn_norm, (bf16_t*)(ws + WS_WF0), 1, 0, first, stride);
        tr_region(lds, p.w_ffn_up, DFF, 2048, DFF, p.g_ffn_norm, (bf16_t*)(ws + WS_WF0), 2, 0, first, stride);
        tr_region(lds, p.w_ffn_down, 2048, DFF, 2048, nullptr, (bf16_t*)(ws + WS_WD0), 0, 0, first, stride);
    }
    if (groups & 2) {
        tr_region(lds, p.w_kv, 4096, 2048, 4096, p.g_kv_norm, (bf16_t*)(ws + WS_WKVQ), 0, 0, first, stride);
        tr_region(lds, p.w_q_b, 2048, 2048, 2048, p.g_norm_b, (bf16_t*)(ws + WS_WKVQ), 0, 4096, first, stride);
        tr_region(lds, p.w_o_b, 2048, 2048, 2048, nullptr, (bf16_t*)(ws + WS_WOB), 0, 0, first, stride);
    }
    if (groups & 4) {
        tr_region(lds, p.w_ffn_gate + (size_t)2048 * DFF, DFF, 2048, DFF, p.g_ffn_norm + 2048, (bf16_t*)(ws + WS_WF1), 1, 0, first, stride);
        tr_region(lds, p.w_ffn_up + (size_t)2048 * DFF, DFF, 2048, DFF, p.g_ffn_norm + 2048, (bf16_t*)(ws + WS_WF1), 2, 0, first, stride);
        tr_region(lds, p.w_ffn_down + (size_t)DFF * 2048, 2048, DFF, 2048, nullptr, (bf16_t*)(ws + WS_WD1), 0, 0, first, stride);
    }
}

template <bool FIRST>
__device__ __forceinline__ void norm_phase(const Params& p, LAS unsigned char* lds) {
    const int tid = opaque_tid(), lane = tid & 63, wave = tid >> 6;
    bf16_t* XN = (bf16_t*)(p.ws + WS_XN);
    const float* HO = (const float*)(p.ws + WS_HO);
    float* AG = (float*)(p.ws + WS_AG);
    LAS float* wl = (LAS float*)lds;
    if (FIRST) {
        for (int e = tid; e < 2048 * 16; e += 512) { const int k = e >> 4, j = e & 15; wl[j * 2048 + k] = p.g_norm_a[k] * p.w_in_a[(size_t)k * NIN + 6144 + j]; }
        __syncthreads();
    }
    const int gw = blockIdx.x * 8 + wave, ngw = gridDim.x * 8;
    for (int r = gw; r < MTOT; r += ngw) {
        const float* src = FIRST ? h0_row(p, r) : HO + (size_t)r * DM;
        f32x4 v[8];
        float ss = 0.f;
#pragma unroll
        for (int j = 0; j < 8; ++j) {
            v[j] = src ? ((const f32x4*)src)[lane + 64 * j] : (f32x4){0.f, 0.f, 0.f, 0.f};
            ss += (v[j][0] * v[j][0] + v[j][1] * v[j][1]) + (v[j][2] * v[j][2] + v[j][3] * v[j][3]);
        }
        const float rstd = rsqrtf(wave_sum(ss) * (1.f / DM) + EPS);
#pragma unroll
        for (int j = 0; j < 8; ++j) {
            v[j] = v[j] * rstd;
            u32x2 o = {cvt_pk_bf16(v[j][0], v[j][1]), cvt_pk_bf16(v[j][2], v[j][3])};
            ((u32x2*)(XN + (size_t)r * DM))[lane + 64 * j] = o;
        }
        if (FIRST) {
            float a16[16];
#pragma unroll
            for (int jj = 0; jj < 16; ++jj) {
                float a = 0.f;
#pragma unroll
                for (int j = 0; j < 8; ++j) { const f32x4 w4 = *(const LAS f32x4*)(wl + jj * 2048 + 4 * (lane + 64 * j)); a += (v[j][0] * w4[0] + v[j][1] * w4[1]) + (v[j][2] * w4[2] + v[j][3] * w4[3]); }
                a16[jj] = a;
            }
            float b8[8], c4[4], d2[2];
            const bool h32 = lane & 32, h16 = lane & 16, h8 = lane & 8, h4 = lane & 4;
#pragma unroll
            for (int j = 0; j < 8; ++j) { const float mine = h32 ? a16[j + 8] : a16[j], other = h32 ? a16[j] : a16[j + 8]; b8[j] = mine + __shfl_xor(other, 32); }
#pragma unroll
            for (int j = 0; j < 4; ++j) { const float mine = h16 ? b8[j + 4] : b8[j], other = h16 ? b8[j] : b8[j + 4]; c4[j] = mine + __shfl_xor(other, 16); }
#pragma unroll
            for (int j = 0; j < 2; ++j) { const float mine = h8 ? c4[j + 2] : c4[j], other = h8 ? c4[j] : c4[j + 2]; d2[j] = mine + __shfl_xor(other, 8); }
            float e1 = (h4 ? d2[1] : d2[0]) + __shfl_xor(h4 ? d2[0] : d2[1], 4);
            e1 += __shfl_xor(e1, 2); e1 += __shfl_xor(e1, 1);
            if ((lane & 3) == 0) AG[(size_t)r * 16 + (lane >> 2)] = e1;
        }
    }
}

__device__ __forceinline__ void knorm_phase(const Params& p) {
    const int tid = opaque_tid(), lane = tid & 63, wave = tid >> 6;
    bf16_t* KR = (bf16_t*)(p.ws + WS_KR);
    const int gw = blockIdx.x * 8 + wave, ngw = gridDim.x * 8;
    for (int r = gw; r < MTOT; r += ngw) {
#pragma unroll
        for (int i = 0; i < 4; ++i) {
            const int ch = lane + 64 * i;
            u32x4 w = ((const u32x4*)(KR + (size_t)r * DM))[ch];
            float f[8] = {bf_lo(w[0]), bf_hi(w[0]), bf_lo(w[1]), bf_hi(w[1]), bf_lo(w[2]), bf_hi(w[2]), bf_lo(w[3]), bf_hi(w[3])};
            float ss = 0.f;
#pragma unroll
            for (int e = 0; e < 8; ++e) ss += f[e] * f[e];
            ss += __shfl_xor(ss, 1); ss += __shfl_xor(ss, 2); ss += __shfl_xor(ss, 4); ss += __shfl_xor(ss, 8);
            const float rstd = rsqrtf(ss * (1.f / 128.f) + EPS);
            const int d0 = (ch & 15) * 8;
            const f32x4 ga = *(const f32x4*)(p.g_k + d0), gb = *(const f32x4*)(p.g_k + d0 + 4);
            u32x4 o = {cvt_pk_bf16(f[0] * rstd * ga[0], f[1] * rstd * ga[1]), cvt_pk_bf16(f[2] * rstd * ga[2], f[3] * rstd * ga[3]),
                       cvt_pk_bf16(f[4] * rstd * gb[0], f[5] * rstd * gb[1]), cvt_pk_bf16(f[6] * rstd * gb[2], f[7] * rstd * gb[3])};
            ((u32x4*)(KR + (size_t)r * DM))[ch] = o;
        }
    }
}

__device__ __forceinline__ void gla_intra_phase(const Params& p, LAS unsigned char* lds, int u_first, int u_end, int u_stride) {
    const int tid = opaque_tid(), lane = tid & 63, wave = __builtin_amdgcn_readfirstlane(tid >> 6), fr = lane & 15, fq = lane >> 4;
    bf16_t* QA = (bf16_t*)(p.ws + WS_QA); const bf16_t* KA = (const bf16_t*)(p.ws + WS_KA); const bf16_t* VTA = (const bf16_t*)(p.ws + WS_VTA);
    bf16_t* KST = (bf16_t*)(p.ws + WS_KST); float* HO = (float*)(p.ws + WS_HO); float* DCB = (float*)(p.ws + WS_DC); const float* AG = (const float*)(p.ws + WS_AG);
    constexpr int OPS = 264;
    LAS bf16_t* QLO = (LAS bf16_t*)lds; LAS bf16_t* KLO = QLO + 64 * OPS; LAS bf16_t* QUP = KLO + 64 * OPS; LAS bf16_t* KUP = QUP + 64 * OPS;
    LAS bf16_t* PS = KUP + 64 * OPS;
    LAS bf16_t* VT = (LAS bf16_t*)lds;
    LAS float* PART = (LAS float*)(lds + 144384);
    for (int u = u_first; u < u_end; u += u_stride) {
        const int b = u / 264, rem = u - b * 264, c = rem >> 2, h = rem & 3;
        const int r0 = b * LTOT + c * 64;
        {
            const int dp = tid & 127, rq = __builtin_amdgcn_readfirstlane(tid >> 7), dcol = h * 256 + 2 * dp;
            float w0[16], w1[16];
#pragma unroll
            for (int rr = 0; rr < 16; ++rr) { const f32x2_t t = *(const f32x2_t*)(p.w_gate_up_a + rr * GKD + dcol); w0[rr] = t[0]; w1[rr] = t[1]; }
            const f32x2_t bg = *(const f32x2_t*)(p.b_gate_a + dcol);
            float bc0[16], bc1[16]; float run0 = 0.f, run1 = 0.f;
#pragma unroll
            for (int sI = 0; sI < 16; ++sI) {
                const float* ar = AG + (size_t)(r0 + rq * 16 + sI) * 16;
                float x0 = bg[0], x1 = bg[1];
#pragma unroll
                for (int rr = 0; rr < 16; ++rr) { const float av = ar[rr]; x0 += av * w0[rr]; x1 += av * w1[rr]; }
                run0 += log_sigmoid_f(x0) * 0.0625f; run1 += log_sigmoid_f(x1) * 0.0625f;
                bc0[sI] = run0; bc1[sI] = run1;
            }
            *(LAS f32x2_t*)(PART + rq * 256 + 2 * dp) = (f32x2_t){run0, run1};
            __syncthreads();
            const f32x2_t t0 = *(const LAS f32x2_t*)(PART + 2 * dp), t1 = *(const LAS f32x2_t*)(PART + 256 + 2 * dp), t2 = *(const LAS f32x2_t*)(PART + 512 + 2 * dp), t3 = *(const LAS f32x2_t*)(PART + 768 + 2 * dp);
            const float ref0 = t0[0] + t1[0], ref1 = t0[1] + t1[1];
            const float bl0 = ref0 + t2[0] + t3[0], bl1 = ref1 + t2[1] + t3[1];
            const float pre0 = (rq > 0 ? t0[0] : 0.f) + (rq > 1 ? t1[0] : 0.f) + (rq > 2 ? t2[0] : 0.f);
            const float pre1 = (rq > 0 ? t0[1] : 0.f) + (rq > 1 ? t1[1] : 0.f) + (rq > 2 ? t2[1] : 0.f);
            unsigned kst0[8], kst1[8];
#pragma unroll
            for (int sI = 0; sI < 16; ++sI) {
                const int rl = rq * 16 + sI;
                const size_t gofs = (size_t)(r0 + rl) * GKD + dcol;
                const unsigned qraw = *(const unsigned*)(QA + gofs), kraw = *(const unsigned*)(KA + gofs);
                const float q0 = bf_lo(qraw), q1 = bf_hi(qraw), k0 = bf_lo(kraw), k1 = bf_hi(kraw);
                const float v0 = bc0[sI] + pre0, v1 = bc1[sI] + pre1;
                const float e10 = __expf(v0 - ref0), e11 = __expf(v1 - ref1), e20 = __expf(ref0 - v0), e21 = __expf(ref1 - v1);
                *(LAS unsigned*)(QLO + rl * OPS + 2 * dp) = cvt_pk_bf16_v(q0 * e10, q1 * e11);
                *(LAS unsigned*)(KUP + rl * OPS + 2 * dp) = cvt_pk_bf16_v(k0 * e10, k1 * e11);
                *(LAS unsigned*)(QUP + rl * OPS + 2 * dp) = cvt_pk_bf16_v(q0 * e20, q1 * e21);
                *(LAS unsigned*)(KLO + rl * OPS + 2 * dp) = cvt_pk_bf16_v(k0 * e20, k1 * e21);
                *(unsigned*)(QA + gofs) = cvt_pk_bf16_v(q0 * __expf(v0), q1 * __expf(v1));
                const float ks0 = k0 * __expf(bl0 - v0), ks1 = k1 * __expf(bl1 - v1);
                if (sI & 1) { kst0[sI >> 1] = cvt_pk_bf16_v(bf_lo(kst0[sI >> 1]), ks0); kst1[sI >> 1] = cvt_pk_bf16_v(bf_lo(kst1[sI >> 1]), ks1); }
                else { kst0[sI >> 1] = cvt_pk_bf16_v(ks0, 0.f); kst1[sI >> 1] = cvt_pk_bf16_v(ks1, 0.f); }
            }
            bf16_t* kd = KST + (size_t)u * 16384 + (size_t)(2 * dp) * 64 + rq * 16;
            *(u32x4*)(kd) = (u32x4){kst0[0], kst0[1], kst0[2], kst0[3]}; *(u32x4*)(kd + 8) = (u32x4){kst0[4], kst0[5], kst0[6], kst0[7]};
            *(u32x4*)(kd + 64) = (u32x4){kst1[0], kst1[1], kst1[2], kst1[3]}; *(u32x4*)(kd + 72) = (u32x4){kst1[4], kst1[5], kst1[6], kst1[7]};
            if (rq == 0) *(f32x2_t*)(DCB + u * 256 + 2 * dp) = (f32x2_t){__expf(bl0), __expf(bl1)};
        }
        __syncthreads();
        u32x4 vreg[8];
#pragma unroll
        for (int i = 0; i < 8; ++i) { const int ch = tid + 512 * i, dv = ch >> 3, part = ch & 7; vreg[i] = *(const u32x4*)(VTA + ((size_t)((b * 4 + h) * 512 + dv)) * LTOT + c * 64 + part * 8); }
#pragma unroll
        for (int bi = 0; bi < 2; ++bi) {
            const int blk = wave * 2 + bi, tb = blk >> 2, sb = blk & 3;
            f32x4 lo = {0.f, 0.f, 0.f, 0.f}, up = {0.f, 0.f, 0.f, 0.f};
            if (tb >= sb) {
#pragma unroll
                for (int ks = 0; ks < 8; ++ks) {
                    const bf16x8 af = *(const LAS bf16x8*)(QLO + (tb * 16 + fr) * OPS + ks * 32 + fq * 8), bf = *(const LAS bf16x8*)(KLO + (sb * 16 + fr) * OPS + ks * 32 + fq * 8);
                    lo = __builtin_amdgcn_mfma_f32_16x16x32_bf16(af, bf, lo, 0, 0, 0);
                }
            }
            if (tb <= sb) {
#pragma unroll
                for (int ks = 0; ks < 8; ++ks) {
                    const bf16x8 af = *(const LAS bf16x8*)(QUP + (tb * 16 + fr) * OPS + ks * 32 + fq * 8), bf = *(const LAS bf16x8*)(KUP + (sb * 16 + fr) * OPS + ks * 32 + fq * 8);
                    up = __builtin_amdgcn_mfma_f32_16x16x32_bf16(af, bf, up, 0, 0, 0);
                }
            }
#pragma unroll
            for (int i = 0; i < 4; ++i) {
                const int t = tb * 16 + fq * 4 + i, s = sb * 16 + fr;
                const float val = (t >= s) ? lo[i] : up[i];
                PS[t * 72 + s] = (bf16_t)(cvt_pk_bf16_v(val, 0.f) & 0xffffu);
            }
        }
        __syncthreads();
#pragma unroll
        for (int i = 0; i < 8; ++i) { const int ch = tid + 512 * i, dv = ch >> 3, part = ch & 7; *(LAS u32x4*)(VT + dv * 72 + part * 8) = vreg[i]; }
        __syncthreads();
#pragma unroll
        for (int tb = 0; tb < 4; ++tb) {
            const bf16x8 a0 = *(const LAS bf16x8*)(PS + (tb * 16 + fr) * 72 + fq * 8), a1 = *(const LAS bf16x8*)(PS + (tb * 16 + fr) * 72 + 32 + fq * 8);
#pragma unroll
            for (int j = 0; j < 4; ++j) {
                const int dvb = wave * 4 + j;
                const bf16x8 b0 = *(const LAS bf16x8*)(VT + (dvb * 16 + fr) * 72 + fq * 8), b1 = *(const LAS bf16x8*)(VT + (dvb * 16 + fr) * 72 + 32 + fq * 8);
                f32x4 o = {0.f, 0.f, 0.f, 0.f};
                o = __builtin_amdgcn_mfma_f32_16x16x32_bf16(a0, b0, o, 0, 0, 0);
                o = __builtin_amdgcn_mfma_f32_16x16x32_bf16(a1, b1, o, 0, 0, 0);
#pragma unroll
                for (int i = 0; i < 4; ++i) HO[(size_t)(r0 + tb * 16 + fq * 4 + i) * DM + h * 512 + dvb * 16 + fr] = o[i];
            }
        }
        __syncthreads();
    }
}

__device__ __forceinline__ void gla_scan_phase(const Params& p, LAS unsigned char* lds) {
    constexpr int LEFT_CNT = 3520;
    unsigned* barw = (unsigned*)(p.ws + WS_BAR);
    if (blockIdx.x >= 128) {
        if (gridDim.x == 256) {
            if (blockIdx.x < 144) {
                gla_intra_phase(p, lds, 512 + (int)blockIdx.x - 128, 528, 1 << 20);
                asm volatile("s_waitcnt vmcnt(0)" ::: "memory");
                __syncthreads();
                if (threadIdx.x == 0) { __builtin_amdgcn_fence(__ATOMIC_RELEASE, "agent"); asm volatile("s_waitcnt vmcnt(0)" ::: "memory"); (void)xb_add(&barw[LEFT_CNT], 1u); }
            }
            tr_deferred(p, lds, (int)blockIdx.x - 128, 128, 2);
        }
        return;
    }
    const int tid = opaque_tid(), lane = tid & 63, wave = __builtin_amdgcn_readfirstlane(tid >> 6), fr = lane & 15, fq = lane >> 4;
    const int id = blockIdx.x, bh = id & 7, sl = id >> 3, b = bh >> 2, h = bh & 3, dv0 = sl * 32;
    const bf16_t* QA = (const bf16_t*)(p.ws + WS_QA); const bf16_t* VTA = (const bf16_t*)(p.ws + WS_VTA); const bf16_t* KST = (const bf16_t*)(p.ws + WS_KST);
    bf16_t* OI = (bf16_t*)(p.ws + WS_XN); const float* DCB = (const float*)(p.ws + WS_DC);
    LAS bf16_t* QI_s0 = (LAS bf16_t*)lds;
    LAS bf16_t* VT_s0 = (LAS bf16_t*)(lds + 67584);
    LAS float* DC_s0 = (LAS float*)(lds + 76800);
    LAS bf16_t* ST_s = (LAS bf16_t*)(lds + 78848);
    for (int e = tid; e < 32 * 264 / 2; e += 512) ((LAS unsigned*)ST_s)[e] = 0u;
    f32x4 S[2][2];
#pragma unroll
    for (int i = 0; i < 2; ++i)
#pragma unroll
        for (int j = 0; j < 2; ++j) S[i][j] = (f32x4){0.f, 0.f, 0.f, 0.f};
    const int tb = wave & 3, vb = wave >> 2;
    const bf16_t* kbase = KST + (size_t)(b * 264 + h) * 16384 + (size_t)(wave * 32 + fr) * 64 + fq * 8;
    u32x4 rqA[4], rvA = {0u, 0u, 0u, 0u}; bf16x8 kfA[2][2]; f32x4 rdcA = {0.f, 0.f, 0.f, 0.f}; float hoA[4];
    u32x4 rqB[4], rvB = {0u, 0u, 0u, 0u}; bf16x8 kfB[2][2]; f32x4 rdcB = {0.f, 0.f, 0.f, 0.f}; float hoB[4];
#define GLA_ISSUE(rq, kf, rv, rdc, ho, cstep) do { const int _c = (cstep); const int _r0 = b * LTOT + _c * 64; const int _u = b * 264 + _c * 4 + h; \
        _Pragma("unroll") for (int i = 0; i < 4; ++i) { const int ch = tid + 512 * i; rq[i] = *(const u32x4*)(QA + (size_t)(_r0 + (ch >> 5)) * GKD + h * 256 + (ch & 31) * 8); } \
        _Pragma("unroll") for (int di = 0; di < 2; ++di) { _Pragma("unroll") for (int ks = 0; ks < 2; ++ks) kf[di][ks] = *(const bf16x8*)(kbase + (size_t)_c * 65536 + di * 1024 + ks * 32); } \
        rv = *(const u32x4*)(VTA + ((size_t)((b * 4 + h) * 512 + dv0 + ((tid & 255) >> 3))) * LTOT + _c * 64 + (tid & 7) * 8); \
        rdc = ((const f32x4*)(DCB + _u * 256))[tid & 63]; \
        (void)ho; } while (0)
#define GLA_STEP(rq, kf, rv, rdc, ho, cstep) do { const int c = (cstep); const int cur = c & 1; \
        if (c == 60 && b == 1 && gridDim.x == 256) {     \
            if (threadIdx.x == 0) { XB_SPIN(xb_ld(&barw[LEFT_CNT]) < 16u, barw); __builtin_amdgcn_fence(__ATOMIC_ACQUIRE, "agent"); asm volatile("s_waitcnt vmcnt(0)" ::: "memory"); } \
            __syncthreads(); } \
        LAS bf16_t* QI_s = QI_s0 + cur * (64 * 264); LAS bf16_t* VT_s = VT_s0 + cur * (32 * 72); LAS float* DC_s = DC_s0 + cur * 256; \
        _Pragma("unroll") for (int i = 0; i < 4; ++i) { const int ch = tid + 512 * i; *(LAS u32x4*)(QI_s + (ch >> 5) * 264 + (ch & 31) * 8) = rq[i]; } \
        if (tid < 256) *(LAS u32x4*)(VT_s + (tid >> 3) * 72 + (tid & 7) * 8) = rv; \
        if (tid < 64) *(LAS f32x4*)(DC_s + tid * 4) = rdc; \
        const bf16x8 k00 = kf[0][0], k01 = kf[0][1], k10 = kf[1][0], k11 = kf[1][1]; \
        const int r0 = b * LTOT + c * 64; \
        GLA_ISSUE(rq, kf, rv, rdc, ho, (c + 2 < 66 ? c + 2 : 65));     \
        __syncthreads(); \
        { f32x4 o = {0.f, 0.f, 0.f, 0.f}; \
          LAS const bf16_t* st = ST_s + cur * (32 * 264); \
          _Pragma("unroll") for (int ks = 0; ks < 8; ++ks) { \
              const bf16x8 af = *(const LAS bf16x8*)(QI_s + (tb * 16 + fr) * 264 + ks * 32 + fq * 8), bf = *(const LAS bf16x8*)(st + (vb * 16 + fr) * 264 + ks * 32 + fq * 8); \
              o = __builtin_amdgcn_mfma_f32_16x16x32_bf16(af, bf, o, 0, 0, 0); } \
            \
          _Pragma("unroll") for (int i = 0; i < 4; ++i) OI[(size_t)(r0 + tb * 16 + fq * 4 + i) * DM + h * 512 + dv0 + vb * 16 + fr] = (bf16_t)(cvt_pk_bf16_v(o[i], 0.f) & 0xffffu); } \
        { LAS bf16_t* stn = ST_s + (cur ^ 1) * (32 * 264); \
          _Pragma("unroll") for (int di = 0; di < 2; ++di) { \
              const int db = wave * 2 + di; \
              const f32x4 dc = *(const LAS f32x4*)(DC_s + db * 16 + fq * 4); \
              const bf16x8 a0 = di ? k10 : k00, a1 = di ? k11 : k01; \
              _Pragma("unroll") for (int vj = 0; vj < 2; ++vj) { \
                  const bf16x8 b0 = *(const LAS bf16x8*)(VT_s + (vj * 16 + fr) * 72 + fq * 8), b1 = *(const LAS bf16x8*)(VT_s + (vj * 16 + fr) * 72 + 32 + fq * 8); \
                  f32x4 sv = S[di][vj] * dc; \
                  sv = __builtin_amdgcn_mfma_f32_16x16x32_bf16(a0, b0, sv, 0, 0, 0); \
                  sv = __builtin_amdgcn_mfma_f32_16x16x32_bf16(a1, b1, sv, 0, 0, 0); \
                  S[di][vj] = sv; \
                  const u32x2 wv = {cvt_pk_bf16_v(sv[0], sv[1]), cvt_pk_bf16_v(sv[2], sv[3])}; \
                  *(LAS u32x2*)(stn + (vj * 16 + fr) * 264 + db * 16 + fq * 4) = wv; } } } \
        } while (0)
    GLA_ISSUE(rqA, kfA, rvA, rdcA, hoA, 0);
    GLA_ISSUE(rqB, kfB, rvB, rdcB, hoB, 1);
#pragma unroll 11
    for (int cc = 0; cc < 66; cc += 2) {
        GLA_STEP(rqA, kfA, rvA, rdcA, hoA, cc);
        GLA_STEP(rqB, kfB, rvB, rdcB, hoB, cc + 1);
    }
    __syncthreads();
#undef GLA_STEP
#undef GLA_ISSUE
}

__device__ __forceinline__ void gla_out_phase(const Params& p) {
    const int tid = opaque_tid(), lane = tid & 63, wave = tid >> 6;
    const float* HO = (const float*)(p.ws + WS_HO); const bf16_t* GA = (const bf16_t*)(p.ws + WS_GA); bf16_t* OG = (bf16_t*)(p.ws + WS_OG);
    const bf16_t* OI = (const bf16_t*)(p.ws + WS_XN);
    const int gw = blockIdx.x * 8 + wave, ngw = gridDim.x * 8;
    for (int it = gw; it < MTOT * 4; it += ngw) {
        const int r = it >> 2, h = it & 3;
        const size_t base = (size_t)r * DM + h * 512 + lane * 8;
        f32x4 o0 = *(const f32x4*)(HO + base), o1 = *(const f32x4*)(HO + base + 4);
        { const u32x4 oi = *(const u32x4*)(OI + base); o0[0] += bf_lo(oi[0]); o0[1] += bf_hi(oi[0]); o0[2] += bf_lo(oi[1]); o0[3] += bf_hi(oi[1]); o1[0] += bf_lo(oi[2]); o1[1] += bf_hi(oi[2]); o1[2] += bf_lo(oi[3]); o1[3] += bf_hi(oi[3]); }
        float ss = (o0[0] * o0[0] + o0[1] * o0[1]) + (o0[2] * o0[2] + o0[3] * o0[3]) + (o1[0] * o1[0] + o1[1] * o1[1]) + (o1[2] * o1[2] + o1[3] * o1[3]);
        const float rstd = rsqrtf(wave_sum(ss) * (1.f / 512.f) + EPS);
        const f32x4 g0 = *(const f32x4*)(p.g_onorm_a + lane * 8), g1 = *(const f32x4*)(p.g_onorm_a + lane * 8 + 4);
        const u32x4 gw4 = *(const u32x4*)(GA + base);
        u32x4 w = {cvt_pk_bf16_v(o0[0] * rstd * g0[0] * bf_lo(gw4[0]), o0[1] * rstd * g0[1] * bf_hi(gw4[0])), cvt_pk_bf16_v(o0[2] * rstd * g0[2] * bf_lo(gw4[1]), o0[3] * rstd * g0[3] * bf_hi(gw4[1])),
                   cvt_pk_bf16_v(o1[0] * rstd * g1[0] * bf_lo(gw4[2]), o1[1] * rstd * g1[1] * bf_hi(gw4[2])), cvt_pk_bf16_v(o1[2] * rstd * g1[2] * bf_lo(gw4[3]), o1[3] * rstd * g1[3] * bf_hi(gw4[3]))};
        *(u32x4*)(OG + base) = w;
    }
}

__device__ __forceinline__ void attn_phase(const Params& p, LAS unsigned char* lds) {
    const int tid = opaque_tid(), lane = tid & 63, wave = __builtin_amdgcn_readfirstlane(tid >> 6), r = lane & 31, hh = lane >> 5;
    const bf16_t* QR = (const bf16_t*)(p.ws + WS_QR); const bf16_t* KN = (const bf16_t*)(p.ws + WS_KR); const bf16_t* VTB = (const bf16_t*)(p.ws + WS_VTB);
    bf16_t* OB = (bf16_t*)(p.ws + WS_OB);
    LAS bf16_t* K_s = (LAS bf16_t*)lds;
    LAS bf16_t* V_s = (LAS bf16_t*)(lds + 17408);
    LAS int* FLG = (LAS int*)(lds + 17408 + 18432);
    float gk[8];
    { const f32x4 ga = *(const f32x4*)(p.g_k + (tid & 15) * 8), gb = *(const f32x4*)(p.g_k + (tid & 15) * 8 + 4);
      gk[0] = ga[0]; gk[1] = ga[1]; gk[2] = ga[2]; gk[3] = ga[3]; gk[4] = gb[0]; gk[5] = gb[1]; gk[6] = gb[2]; gk[7] = gb[3]; }
    bf16x8 Tf[2];
#pragma unroll
    for (int s = 0; s < 2; ++s)
#pragma unroll
        for (int j = 0; j < 8; ++j) { const int key = 16 * s + 8 * (j >> 2) + 4 * hh + (j & 3); Tf[s][j] = (key >= r) ? (short)0x3F80 : (short)0; }
    for (int it = blockIdx.x; it < 544; it += gridDim.x) {
        int qb; if (it < 256) qb = 16 - (it >> 5); else if (it < 512) qb = 1 + ((it - 256) >> 5); else qb = 0;
        const int bhh = it & 31, b = bhh >> 4, h = bhh & 15;
        const int q0 = -128 + 256 * qb;
        const int qpos = q0 + 32 * wave + r;
        const int qmax_w = q0 + 32 * wave + 31;
        const bool wact = qmax_w >= PADN;
        bf16x8 qf[8];
        if (wact) {
            u32x4 raw[8]; float ss = 0.f;
#pragma unroll
            for (int ks = 0; ks < 8; ++ks) {
                raw[ks] = *(const u32x4*)(QR + (size_t)(b * LTOT + qpos) * DM + h * 128 + 16 * ks + 8 * hh);
#pragma unroll
                for (int e = 0; e < 4; ++e) { const float lo = bf_lo(raw[ks][e]), hi = bf_hi(raw[ks][e]); ss += lo * lo + hi * hi; }
            }
            ss += __shfl_xor(ss, 32);
            const float sc = rsqrtf(ss * (1.f / 128.f) + EPS) * (0.08838834764831845f * 1.4426950408889634f);
#pragma unroll
            for (int ks = 0; ks < 8; ++ks) {
                const f32x4 ga = *(const f32x4*)(p.g_q_b + 16 * ks + 8 * hh), gb = *(const f32x4*)(p.g_q_b + 16 * ks + 8 * hh + 4);
                u32x4 w = {cvt_pk_bf16_v(bf_lo(raw[ks][0]) * sc * ga[0], bf_hi(raw[ks][0]) * sc * ga[1]), cvt_pk_bf16_v(bf_lo(raw[ks][1]) * sc * ga[2], bf_hi(raw[ks][1]) * sc * ga[3]),
                           cvt_pk_bf16_v(bf_lo(raw[ks][2]) * sc * gb[0], bf_hi(raw[ks][2]) * sc * gb[1]), cvt_pk_bf16_v(bf_lo(raw[ks][3]) * sc * gb[2], bf_hi(raw[ks][3]) * sc * gb[3])};
                qf[ks] = __builtin_bit_cast(bf16x8, w);
            }
        } else {
#pragma unroll
            for (int ks = 0; ks < 8; ++ks) qf[ks] = (bf16x8){0, 0, 0, 0, 0, 0, 0, 0};
        }
        f32x16 O[4];
#pragma unroll
        for (int d = 0; d < 4; ++d)
#pragma unroll
            for (int i = 0; i < 16; ++i) O[d][i] = 0.f;
        float carry = 0.f;
        bool wdone = !wact;
        const int kt_hi = (q0 + 254) >> 6;
        u32x4 rkk[2], rvv[2];
#define ATT_ISSUE(ktile) do { const int _k0 = (ktile) * 64; \
        _Pragma("unroll") for (int i = 0; i < 2; ++i) { const int ch = tid + 512 * i; \
            rkk[i] = *(const u32x4*)(KN + (size_t)(b * LTOT + _k0 + (ch >> 4)) * DM + h * 128 + (ch & 15) * 8); \
            rvv[i] = *(const u32x4*)(VTB + ((size_t)((b * 16 + h) * 128 + (ch >> 3))) * LTOT + _k0 + (ch & 7) * 8); } } while (0)
        ATT_ISSUE(kt_hi);
        for (int kt = kt_hi; kt >= 1; --kt) {
#pragma unroll
            for (int i = 0; i < 2; ++i) { const int ch = tid + 512 * i;
                const u32x4 w = rkk[i];
                float f[8] = {bf_lo(w[0]), bf_hi(w[0]), bf_lo(w[1]), bf_hi(w[1]), bf_lo(w[2]), bf_hi(w[2]), bf_lo(w[3]), bf_hi(w[3])};
                float ss = 0.f;
#pragma unroll
                for (int e = 0; e < 8; ++e) ss += f[e] * f[e];
                ss += __shfl_xor(ss, 1); ss += __shfl_xor(ss, 2); ss += __shfl_xor(ss, 4); ss += __shfl_xor(ss, 8);
                const float rs = rsqrtf(ss * (1.f / 128.f) + EPS);
                const u32x4 o = {cvt_pk_bf16_v(f[0] * rs * gk[0], f[1] * rs * gk[1]), cvt_pk_bf16_v(f[2] * rs * gk[2], f[3] * rs * gk[3]),
                                 cvt_pk_bf16_v(f[4] * rs * gk[4], f[5] * rs * gk[5]), cvt_pk_bf16_v(f[6] * rs * gk[6], f[7] * rs * gk[7])};
                *(LAS u32x4*)(K_s + (ch >> 4) * 136 + (ch & 15) * 8) = o; *(LAS u32x4*)(V_s + (ch >> 3) * 72 + (ch & 7) * 8) = rvv[i]; }
            if (kt > 1) ATT_ISSUE(kt - 1);
            __syncthreads();
            if (!wdone) {
#pragma unroll
                for (int sub = 1; sub >= 0; --sub) {
                    const int kb0 = kt * 64 + sub * 32;
                    if (kb0 <= qmax_w - 1 && kb0 + 31 >= PADN) {
                        f32x16 Z;
#pragma unroll
                        for (int i = 0; i < 16; ++i) Z[i] = 0.f;
#pragma unroll
                        for (int ks = 0; ks < 8; ++ks) {
                            const bf16x8 kf = *(const LAS bf16x8*)(K_s + (sub * 32 + r) * 136 + 16 * ks + 8 * hh);
                            Z = __builtin_amdgcn_mfma_f32_32x32x16_bf16(kf, qf[ks], Z, 0, 0, 0);
                        }
                        float lf[16]; float tot = 0.f; unsigned vmask = 0xffffu;
                        const bool interior = (kb0 + 31 < q0 + 32 * wave) && (kb0 >= PADN);
                        if (interior) {
#pragma unroll
                            for (int i = 0; i < 16; ++i) { lf[i] = log2_sigmoid2_f(-Z[i]); tot += lf[i]; }
                        } else {
                            vmask = 0u;
#pragma unroll
                            for (int i = 0; i < 16; ++i) {
                                const int key = kb0 + (i & 3) + 8 * (i >> 2) + 4 * hh;
                                const bool valid = (key < qpos) && (key >= PADN);
                                vmask |= valid ? (1u << i) : 0u;
                                lf[i] = valid ? log2_sigmoid2_f(-Z[i]) : 0.f;
                                tot += lf[i];
                            }
                        }
                        tot += __shfl_xor(tot, 32);
                        f32x16 Y;
#pragma unroll
                        for (int i = 0; i < 16; ++i) Y[i] = 0.f;
#pragma unroll
                        for (int s = 0; s < 2; ++s) {
                            unsigned hi4[4], lo4[4];
#pragma unroll
                            for (int e = 0; e < 4; ++e) {
                                const float x0 = lf[8 * s + 2 * e], x1 = lf[8 * s + 2 * e + 1];
                                const unsigned hw = cvt_pk_bf16_v(x0, x1);
                                hi4[e] = hw; lo4[e] = cvt_pk_bf16_v(x0 - bf_lo(hw), x1 - bf_hi(hw));
                            }
                            const u32x4 hv = {hi4[0], hi4[1], hi4[2], hi4[3]}, lv = {lo4[0], lo4[1], lo4[2], lo4[3]};
                            Y = __builtin_amdgcn_mfma_f32_32x32x16_bf16(Tf[s], __builtin_bit_cast(bf16x8, hv), Y, 0, 0, 0);
                            Y = __builtin_amdgcn_mfma_f32_32x32x16_bf16(Tf[s], __builtin_bit_cast(bf16x8, lv), Y, 0, 0, 0);
                        }
                        float att[16];
#pragma unroll
                        for (int i = 0; i < 16; ++i) att[i] = __builtin_amdgcn_exp2f(Z[i] + Y[i] + carry);
                        if (!interior) {
#pragma unroll
                            for (int i = 0; i < 16; ++i) att[i] = ((vmask >> i) & 1u) ? att[i] : 0.f;
                        }
                        carry += tot;
                        bf16x8 pa[2];
#pragma unroll
                        for (int s = 0; s < 2; ++s) {
                            const u32x4 w = {cvt_pk_bf16_v(att[8 * s], att[8 * s + 1]), cvt_pk_bf16_v(att[8 * s + 2], att[8 * s + 3]), cvt_pk_bf16_v(att[8 * s + 4], att[8 * s + 5]), cvt_pk_bf16_v(att[8 * s + 6], att[8 * s + 7])};
                            pa[s] = __builtin_bit_cast(bf16x8, w);
                        }
#pragma unroll
                        for (int dvb = 0; dvb < 4; ++dvb)
#pragma unroll
                            for (int s = 0; s < 2; ++s) {
                                const u32x2 v0 = *(const LAS u32x2*)(V_s + (dvb * 32 + r) * 72 + sub * 32 + 16 * s + 4 * hh);
                                const u32x2 v1 = *(const LAS u32x2*)(V_s + (dvb * 32 + r) * 72 + sub * 32 + 16 * s + 8 + 4 * hh);
                                const u32x4 vv = {v0[0], v0[1], v1[0], v1[1]};
                                O[dvb] = __builtin_amdgcn_mfma_f32_32x32x16_bf16(__builtin_bit_cast(bf16x8, vv), pa[s], O[dvb], 0, 0, 0);
                            }
                    }
                }
                if (__all(carry < -152.f)) wdone = true;
            }
            if (lane == 0) FLG[wave] = wdone ? 0 : 1;
            __syncthreads();
            const int anyw = FLG[0] | FLG[1] | FLG[2] | FLG[3] | FLG[4] | FLG[5] | FLG[6] | FLG[7];
            if (!anyw) break;
        }
        __syncthreads();
#undef ATT_ISSUE
        if (wact && qpos >= PADN) {
            bf16_t* orow = OB + (size_t)(b * LTOT + qpos) * DM + h * 128;
#pragma unroll
            for (int dvb = 0; dvb < 4; ++dvb)
#pragma unroll
                for (int g = 0; g < 4; ++g) {
                    const u32x2 w = {cvt_pk_bf16_v(O[dvb][4 * g], O[dvb][4 * g + 1]), cvt_pk_bf16_v(O[dvb][4 * g + 2], O[dvb][4 * g + 3])};
                    *(u32x2*)(orow + dvb * 32 + 8 * g + 4 * hh) = w;
                }
        }
    }
}


#define GRID_SYNC() do { asm volatile("s_waitcnt vmcnt(0)" ::: "memory"); grid.sync(); __builtin_amdgcn_fence(__ATOMIC_ACQUIRE, "agent"); asm volatile("s_waitcnt vmcnt(0)" ::: "memory"); } while (0)
__global__ void __launch_bounds__(512, 2) yoco_fwd(Params p) {
    extern __shared__ __attribute__((aligned(16))) unsigned char lds_raw[];
    LAS unsigned char* lds = (LAS unsigned char*)lds_raw;
    cg::grid_group grid = cg::this_grid();
    unsigned char* ws = p.ws;
    bf16_t* XN = (bf16_t*)(ws + WS_XN);
    float* HO = (float*)(ws + WS_HO);
    const int G = gridDim.x, bid = blockIdx.x;
    volatile LAS unsigned* xst = (volatile LAS unsigned*)(lds + LDS_BYTES - 16);
    if (threadIdx.x < 4) xst[threadIdx.x] = 0u;
    __syncthreads();
    XcdBarrier xb; xb.bar = (unsigned*)(p.ws + WS_BAR); xb.x = 0; xb.st = xst;
    if (p.ph_hi - p.ph_lo > 1) xb = xcd_barrier_post((unsigned*)(p.ws + WS_BAR), xst);
    if (p.ph_lo < 0) grid.sync();

#ifndef MK_DUMP
#define MK_DUMP 0
#endif
#ifndef MK_STOP
#define MK_STOP 17
#endif
#ifndef PROF_A
#define PROF_A -1
#endif
#ifndef PROF_B
#define PROF_B -1
#endif
#ifndef PROF_AMP
#define PROF_AMP 8
#endif
    unsigned long long tA0 = 0, tA1 = 0, tB0 = 0, tB1 = 0;
#define PROF_BEGIN(k) do { if ((k) == PROF_A) tA0 = __builtin_amdgcn_s_memrealtime(); if ((k) == PROF_B) tB0 = __builtin_amdgcn_s_memrealtime(); } while (0)
#define PROF_END(k) do { if ((k) == PROF_A) tA1 = __builtin_amdgcn_s_memrealtime(); if ((k) == PROF_B) tB1 = __builtin_amdgcn_s_memrealtime(); } while (0)
#define IN(k) (p.ph_lo <= (k) && (k) < p.ph_hi)
#define BOTH(k) (IN(k) && IN((k) + 1))
    if (IN(0)) { PROF_BEGIN(0);
    tr_region(lds, p.w_in_a, NIN, 2048, 6144, p.g_norm_a, (bf16_t*)(ws + WS_WIN), 0, 0, blockIdx.x, gridDim.x);
    if (gridDim.x != 256) tr_deferred(p, lds, blockIdx.x, gridDim.x, 7);
    norm_phase<true>(p, lds);
        if (BOTH(0)) xcd_barrier(xb);
        PROF_END(0);
    }
    if (IN(1)) { PROF_BEGIN(1);

    {
        pg8::Gemm g{XN, (const bf16_t*)(ws + WS_WIN), MTOT, 6144, 2048}; pg8::StaticOrder S; S.init(MTOT, 6144, 2048, G, bid);
        EpiIn E{(bf16_t*)(ws + WS_QA), (bf16_t*)(ws + WS_KA), (bf16_t*)(ws + WS_VTA), (bf16_t*)(ws + WS_GA), p.ph_hi > 0 ? 1.0f : 0.0f};
        pg8::gemm_phase<EpiIn, pg8::StaticOrder, true, true>(lds, g, S, E);
        if (G == 256 && bid >= 24) tr_deferred(p, lds, bid - 24, 232, 1);
    }
        if (BOTH(1)) xcd_barrier(xb);
        PROF_END(1);
    }
    if (IN(2)) { PROF_BEGIN(2);
    if (G == 256) gla_intra_phase(p, lds, bid, 512, 256);
    else gla_intra_phase(p, lds, bid, 528, G);
        if (BOTH(2)) xcd_barrier(xb);
        PROF_END(2);
    }
    if (IN(3)) { PROF_BEGIN(3);
    gla_scan_phase(p, lds);
        if (BOTH(3)) xcd_barrier(xb);
        PROF_END(3);
    }
    if (IN(4)) { PROF_BEGIN(4);
    gla_out_phase(p);
        if (BOTH(4)) xcd_barrier(xb);
        PROF_END(4);
    }
    if (IN(5)) { PROF_BEGIN(5);
    {
        pg8::Gemm g{(const bf16_t*)(ws + WS_OG), (const bf16_t*)(ws + WS_WOUTA), MTOT, 2048, 2048}; pg8::TailOrder S; S.init(2048, 2048, G, bid, 8);
        EpiRes<true, false, true> E{p.x, p.meta, p.out, HO, XN, (float*)(ws + WS_SSQ), (float*)(ws + WS_SLAB)};
        pg8::gemm_phase<EpiRes<true, false, true>, pg8::TailOrder, true, true>(lds, g, S, E);
    }
        if (BOTH(5)) xcd_barrier(xb);
        PROF_END(5);
    }
    if (IN(6)) { PROF_BEGIN(6);
    tail_fix_phase<true, false>(p, 8);
        if (BOTH(6)) xcd_barrier(xb);
        PROF_END(6);
    }
    if (IN(7)) { PROF_BEGIN(7);
    {
        pg8::Gemm g{XN, (const bf16_t*)(ws + WS_WF0), MTOT, 2 * DFF, 2048}; pg8::StaticOrder S; S.init(MTOT, 2 * DFF, 2048, G, bid);
        EpiSwiglu E{(bf16_t*)(ws + WS_ACT), (const float*)(ws + WS_SSQ)};
        pg8::gemm_phase<EpiSwiglu, pg8::StaticOrder, true, true>(lds, g, S, E);
    }
        if (BOTH(7)) xcd_barrier(xb);
        PROF_END(7);
    }
    if (IN(8)) { PROF_BEGIN(8);
    {
        pg8::Gemm g{(const bf16_t*)(ws + WS_ACT), (const bf16_t*)(ws + WS_WD0), MTOT, 2048, DFF}; pg8::TailOrder S; S.init(2048, DFF, G, bid, 11);
        EpiRes<false, false, true> E{p.x, p.meta, p.out, HO, XN, (float*)(ws + WS_SSQ), (float*)(ws + WS_SLAB)};
        pg8::gemm_phase<EpiRes<false, false, true>, pg8::TailOrder, true, true>(lds, g, S, E);
    }
        if (BOTH(8)) xcd_barrier(xb);
        PROF_END(8);
    }
    if (IN(9)) { PROF_BEGIN(9);
    tail_fix_phase<false, false>(p, 11);
        if (BOTH(9)) xcd_barrier(xb);
        PROF_END(9);
    }
    if (IN(10)) { PROF_BEGIN(10);
    {
        pg8::Gemm g{XN, (const bf16_t*)(ws + WS_WKVQ), MTOT, 6144, 2048}; pg8::StaticOrder S; S.init(MTOT, 6144, 2048, G, bid);
        EpiKvq E{(bf16_t*)(ws + WS_KR), (bf16_t*)(ws + WS_VTB), (bf16_t*)(ws + WS_QR), (const float*)(ws + WS_SSQ)};
        pg8::gemm_phase<EpiKvq, pg8::StaticOrder, true, true>(lds, g, S, E);
        if (G == 256 && bid >= 24) tr_deferred(p, lds, bid - 24, 232, 4);
    }
        if (BOTH(10)) xcd_barrier(xb);
        PROF_END(10);
    }
    if (IN(11)) { PROF_BEGIN(11);
        PROF_END(11);
    }
    if (IN(12)) { PROF_BEGIN(12);
    attn_phase(p, lds);
        if (BOTH(12)) xcd_barrier(xb);
        PROF_END(12);
    }
    if (IN(13)) { PROF_BEGIN(13);
    {
        pg8::Gemm g{(const bf16_t*)(ws + WS_OB), (const bf16_t*)(ws + WS_WOB), MTOT, 2048, 2048}; pg8::TailOrder S; S.init(2048, 2048, G, bid, 8);
        EpiRes<false, false, true> E{p.x, p.meta, p.out, HO, XN, (float*)(ws + WS_SSQ), (float*)(ws + WS_SLAB)};
        pg8::gemm_phase<EpiRes<false, false, true>, pg8::TailOrder, true, true>(lds, g, S, E);
    }
        if (BOTH(13)) xcd_barrier(xb);
        PROF_END(13);
    }
    if (IN(14)) { PROF_BEGIN(14);
    tail_fix_phase<false, false>(p, 8);
        if (BOTH(14)) xcd_barrier(xb);
        PROF_END(14);
    }
    if (IN(15)) { PROF_BEGIN(15);
    {
        pg8::Gemm g{XN, (const bf16_t*)(ws + WS_WF1), MTOT, 2 * DFF, 2048}; pg8::StaticOrder S; S.init(MTOT, 2 * DFF, 2048, G, bid);
        EpiSwiglu E{(bf16_t*)(ws + WS_ACT), (const float*)(ws + WS_SSQ)};
        pg8::gemm_phase<EpiSwiglu, pg8::StaticOrder, true, true>(lds, g, S, E);
    }
        if (BOTH(15)) xcd_barrier(xb);
        PROF_END(15);
    }
    if (IN(16)) { PROF_BEGIN(16);
    {
        pg8::Gemm g{(const bf16_t*)(ws + WS_ACT), (const bf16_t*)(ws + WS_WD1), MTOT, 2048, DFF}; pg8::TailOrder S; S.init(2048, DFF, G, bid, 11);
        EpiRes<false, true, false> E{p.x, p.meta, p.out, HO, XN, (float*)(ws + WS_SSQ), (float*)(ws + WS_SLAB)};
        pg8::gemm_phase<EpiRes<false, true, false>, pg8::TailOrder, true, true>(lds, g, S, E);
    }
        if (BOTH(16)) xcd_barrier(xb);
        PROF_END(16);
    }
    if (IN(17)) { PROF_BEGIN(17);
    tail_fix_phase<false, true>(p, 11);
    }
    if ((PROF_A != -1 || PROF_B != -1) && p.ph_hi == 18) {
        xcd_barrier(xb);
        if (PROF_A == 17) tA1 = __builtin_amdgcn_s_memrealtime();
        if (PROF_B == 17) tB1 = __builtin_amdgcn_s_memrealtime();
        if (blockIdx.x == 0) {
            const int n = PROF_A == 100 ? 1000 : (PROF_A >= 0 ? (int)((tA1 - tA0) / 100ull) : 0);
            for (int i = opaque_tid(); i < n; i += 512) p.out[(size_t)i * 163 + 7] += 0.2f;
            if (PROF_B >= 0) { const unsigned long long until = __builtin_amdgcn_s_memrealtime() + (tB1 - tB0) * (unsigned long long)PROF_AMP; while (__builtin_amdgcn_s_memrealtime() < until) __builtin_amdgcn_s_sleep(8); }
        }
    }
    if (IN(18)) {
        const int gt = blockIdx.x * 512 + opaque_tid(), ngt = gridDim.x * 512;
        for (size_t i = gt; i < (size_t)BATCH * SEQ * DM; i += ngt) {
            const size_t row = i / DM, c = i - row * DM; const size_t b = row / SEQ, t = row - b * SEQ; const size_t src = (b * LTOT + OFFS + t) * DM + c;
            float v;
            if (MK_DUMP == 0) v = HO[src];
            else if (MK_DUMP == 1) v = bf_lo((unsigned)XN[src]);
            else v = bf_lo((unsigned)((const bf16_t*)(ws + WS_R + (size_t)(MK_DUMP - 2) * SZ_ROW1K))[i]);
            p.out[i] = v;
        }
    }
#undef IN
#undef BOTH
}

extern "C" void kernel_launch(void* const* d_in, const int* in_sizes, int n_in, void* d_out, int out_size, void* d_ws, size_t ws_size, hipStream_t stream) {
    static int grid = 0;
    if (grid == 0) {
        if (n_in != 19 || ws_size < WS_TOTAL) { fprintf(stderr, "kernel_launch: expected 19 inputs and >= %zu bytes of workspace; got %d, %zu\n", (size_t)WS_TOTAL, n_in, ws_size); grid = -1; return; }
        int dev = 0, cus = 0, per_cu = 0;
        hipGetDevice(&dev);
        hipDeviceGetAttribute(&cus, hipDeviceAttributeMultiprocessorCount, dev);
        if (hipFuncSetAttribute((const void*)yoco_fwd, hipFuncAttributeMaxDynamicSharedMemorySize, LDS_BYTES) != hipSuccess) { fprintf(stderr, "kernel_launch: hipFuncSetAttribute failed\n"); grid = -1; return; }
        if (hipOccupancyMaxActiveBlocksPerMultiprocessor(&per_cu, (const void*)yoco_fwd, 512, LDS_BYTES) != hipSuccess || per_cu < 1) { fprintf(stderr, "kernel_launch: occupancy query says %d\n", per_cu); per_cu = 1; }
        (void)hipGetLastError();
        grid = cus * 1;
    }
    if (grid < 0) return;
    if (hipMemsetAsync((char*)d_ws + WS_BAR, 0, 16384, stream) != hipSuccess) { fprintf(stderr, "kernel_launch: memset of the barrier words failed\n"); return; }
    Params p{};
    p.x = (const float*)d_in[0]; p.meta = (const float*)d_in[1]; p.g_norm_a = (const float*)d_in[2]; p.w_in_a = (const float*)d_in[3]; p.w_gate_up_a = (const float*)d_in[4];
    p.b_gate_a = (const float*)d_in[5]; p.g_onorm_a = (const float*)d_in[6]; p.w_out_a = (const float*)d_in[7]; p.g_kv_norm = (const float*)d_in[8]; p.w_kv = (const float*)d_in[9];
    p.g_k = (const float*)d_in[10]; p.g_norm_b = (const float*)d_in[11]; p.w_q_b = (const float*)d_in[12]; p.g_q_b = (const float*)d_in[13]; p.w_o_b = (const float*)d_in[14];
    p.g_ffn_norm = (const float*)d_in[15]; p.w_ffn_gate = (const float*)d_in[16]; p.w_ffn_up = (const float*)d_in[17]; p.w_ffn_down = (const float*)d_in[18];
    p.out = (float*)d_out; p.ws = (unsigned char*)d_ws;
#ifndef MK_SPLIT
#define MK_SPLIT 0
#endif
    constexpr int NPH = 18;
    if (MK_SPLIT) {
        for (int k0 = 0; k0 <= MK_STOP + (MK_STOP < 17 ? 1 : 0); ++k0) {
            const int k = k0 <= MK_STOP ? k0 : 18;
            p.ph_lo = k; p.ph_hi = k + 1;
            void* args[] = {&p};
            hipError_t e = hipLaunchCooperativeKernel((const void*)yoco_fwd, dim3(grid), dim3(512), args, LDS_BYTES, stream);
            if (e != hipSuccess) { fprintf(stderr, "kernel_launch: launch %d failed: %s (grid %d)\n", k, hipGetErrorString(e), grid); break; }
        }
    } else {
        p.ph_lo = 0; p.ph_hi = NPH;
        void* args[] = {&p};
        hipError_t e = hipLaunchCooperativeKernel((const void*)yoco_fwd, dim3(grid), dim3(512), args, LDS_BYTES, stream);
        if (e != hipSuccess) fprintf(stderr, "kernel_launch: cooperative launch failed: %s (grid %d)\n", hipGetErrorString(e), grid);
    }
}
```
